# Optimizing an MI355X kernel written in HIP

```python
import math
import jax, jax.numpy as jnp
from jax import lax
import numpy as np

D_MODEL = 1024
BATCH = 1
SEQ = 16384
DEPTH = 4

MEM_LEN = 256
N_MIXERS = 3
EXPAND = 2
BRANCH = EXPAND * D_MODEL
CONV_WIDTH = 3
DIFF_HEAD_DIM = 64
DIFF_HEADS = BRANCH // (2 * DIFF_HEAD_DIM)
SWA_HEAD_DIM = 64
SWA_Q_HEADS = BRANCH // SWA_HEAD_DIM
SWA_KV_HEADS = SWA_Q_HEADS // 8
WINDOW = 128
Q_BLOCK = 128
MEM_HEADS = 4
MEM_HEAD_DIM = 64
MEM_WIDTH = MEM_HEADS * MEM_HEAD_DIM
GATE_WIDTH = BRANCH + MEM_WIDTH
ALIBI_MAX_BIAS = 8.0
EPS = 1e-6
NEG_INF = -1e30

CONV_COLS = (BRANCH, BRANCH, BRANCH, MEM_WIDTH, GATE_WIDTH)
DIFF_COLS = (DIFF_HEADS * 2 * DIFF_HEAD_DIM, DIFF_HEADS * 2 * DIFF_HEAD_DIM,
             DIFF_HEADS * 2 * DIFF_HEAD_DIM, MEM_WIDTH, GATE_WIDTH)
SWA_COLS = (SWA_Q_HEADS * SWA_HEAD_DIM, SWA_KV_HEADS * SWA_HEAD_DIM,
            SWA_KV_HEADS * SWA_HEAD_DIM, MEM_WIDTH, GATE_WIDTH)

kernel_name = "interleaved_conv_diffattn_swa_sink_hybrid"


def rms_norm(x, g):
    xf = x.astype(jnp.float32)
    y = xf * lax.rsqrt(jnp.mean(xf * xf, axis=-1, keepdims=True) + EPS)
    return (y * g.astype(jnp.float32)).astype(x.dtype)


def split_cols(t, widths):
    idx = [int(v) for v in np.cumsum(widths)[:-1]]
    return jnp.split(t, idx, axis=-1)


def alibi_slopes(n_heads):
    return 2.0 ** (-ALIBI_MAX_BIAS * jnp.arange(1, n_heads + 1, dtype=jnp.float32) / n_heads)


def diff_lambda_init(layer_idx):
    return 0.8 - 0.6 * math.exp(-0.3 * layer_idx)


def short_conv_mixer(bg, cg, u, conv_w):
    s = u.shape[1]
    z = cg * u
    zp = jnp.pad(z, ((0, 0), (CONV_WIDTH - 1, 0), (0, 0)))
    conv = sum(conv_w[j] * zp[:, j:j + s] for j in range(CONV_WIDTH))
    return bg * conv


def diff_attention(q, k, v, positions, lam, slopes):
    b, s = q.shape[:2]
    nb = s // Q_BLOCK
    scale = DIFF_HEAD_DIM ** -0.5
    kf = k.astype(jnp.float32)
    vf = v.astype(jnp.float32)
    qb = jnp.moveaxis(q.reshape(b, nb, Q_BLOCK, DIFF_HEADS, 2, DIFF_HEAD_DIM), 1, 0)
    pb = jnp.moveaxis(positions.reshape(b, nb, Q_BLOCK), 1, 0)

    def block(args):
        q_blk, p_blk = args
        logits = jnp.einsum('bqhcd,bshcd->bchqs', q_blk.astype(jnp.float32), kf) * scale
        rel = p_blk[:, :, None] - positions[:, None, :]
        alibi = -slopes[None, :, None, None] * rel[:, None].astype(jnp.float32)
        logits = jnp.where((rel >= 0)[:, None, None], logits + alibi[:, None], NEG_INF)
        probs = jax.nn.softmax(logits, axis=-1)
        weights = probs[:, 0] - lam * probs[:, 1]
        return jnp.einsum('bhqs,bshe->bqhe', weights, vf)

    out = lax.map(block, (qb, pb))
    return jnp.moveaxis(out, 0, 1).reshape(b, s, DIFF_HEADS, 2 * DIFF_HEAD_DIM)


def swa_with_sinks(q, k, v, positions, sinks, slopes):
    b, s = q.shape[:2]
    nb = s // WINDOW
    g = SWA_Q_HEADS // SWA_KV_HEADS
    scale = SWA_HEAD_DIM ** -0.5
    qb = q.reshape(b, nb, WINDOW, SWA_KV_HEADS, g, SWA_HEAD_DIM).astype(jnp.float32)

    def band(t):
        tb = t.reshape(b, nb, WINDOW, SWA_KV_HEADS, SWA_HEAD_DIM).astype(jnp.float32)
        prev = jnp.pad(tb[:, :-1], ((0, 0), (1, 0), (0, 0), (0, 0), (0, 0)))
        return jnp.concatenate([prev, tb], axis=2)

    kb, vb = band(k), band(v)
    pos_b = positions.reshape(b, nb, WINDOW)
    pos_prev = jnp.pad(pos_b[:, :-1], ((0, 0), (1, 0), (0, 0)))
    pos_band = jnp.concatenate([pos_prev, pos_b], axis=2)
    key_valid = jnp.concatenate(
        [jnp.broadcast_to((jnp.arange(nb) > 0)[:, None], (nb, WINDOW)),
         jnp.ones((nb, WINDOW), dtype=bool)], axis=1)
    rel = pos_b[..., :, None] - pos_band[..., None, :]
    mask = key_valid[None, :, None, :] & (rel >= 0) & (rel < WINDOW)
    logits = jnp.einsum('bnqkgd,bnskd->bnkgqs', qb, kb) * scale
    logits = logits - slopes.reshape(SWA_KV_HEADS, g)[None, None, :, :, None, None] \
        * rel[:, :, None, None].astype(jnp.float32)
    logits = jnp.where(mask[:, :, None, None], logits, NEG_INF)
    sink = sinks.astype(jnp.float32).reshape(SWA_KV_HEADS, g)[None, None, :, :, None, None]
    m = jnp.maximum(jnp.max(logits, axis=-1, keepdims=True), sink)
    e = jnp.exp(logits - m)
    probs = e / (jnp.sum(e, axis=-1, keepdims=True) + jnp.exp(sink - m))
    out = jnp.einsum('bnkgqs,bnskd->bnqkgd', probs, vb)
    return out.reshape(b, s, SWA_Q_HEADS * SWA_HEAD_DIM)


def memory_attention(q, mem_n, w_mem_kv):
    b, s = q.shape[:2]
    kv = jnp.einsum('bmd,de->bme', mem_n, w_mem_kv)
    km, vm = jnp.split(kv, 2, axis=-1)
    km = km.reshape(b, -1, MEM_HEADS, MEM_HEAD_DIM).astype(jnp.float32)
    vm = vm.reshape(b, -1, MEM_HEADS, MEM_HEAD_DIM).astype(jnp.float32)
    qh = q.reshape(b, s, MEM_HEADS, MEM_HEAD_DIM).astype(jnp.float32)
    logits = jnp.einsum('bshd,bmhd->bhsm', qh, km) * (MEM_HEAD_DIM ** -0.5)
    probs = jax.nn.softmax(logits, axis=-1)
    return jnp.einsum('bhsm,bmhd->bshd', probs, vm).reshape(b, s, MEM_WIDTH)


def setup_inputs(seed: int = 0) -> dict:
    key = jax.random.key(seed)
    ks = iter(jax.random.split(key, 64))

    def nrm(shape, scale):
        return scale * jax.random.normal(next(ks), shape, jnp.float32)

    def gain(n):
        return 1.0 + nrm((n,), 0.02)

    inp = {}
    inp["x"] = nrm((BATCH, SEQ, D_MODEL), 1.0)
    inp["mem"] = nrm((BATCH, MEM_LEN, D_MODEL), 1.0)
    inp["positions"] = jnp.broadcast_to(jnp.arange(SEQ, dtype=jnp.int32)[None], (BATCH, SEQ))
    for i in range(DEPTH):
        kind = i % N_MIXERS
        cols = (CONV_COLS, DIFF_COLS, SWA_COLS)[kind]
        inp[f"norm_pre_{i}"] = gain(D_MODEL)
        inp[f"norm_post_{i}"] = gain(D_MODEL)
        inp[f"norm_mem_{i}"] = gain(D_MODEL)
        inp[f"w_in_{i}"] = nrm((D_MODEL, sum(cols)), D_MODEL ** -0.5)
        inp[f"w_mem_kv_{i}"] = nrm((D_MODEL, 2 * MEM_WIDTH), D_MODEL ** -0.5)
        if kind == 0:
            inp[f"conv_w_{i}"] = nrm((CONV_WIDTH, BRANCH), CONV_WIDTH ** -0.5)
        elif kind == 1:
            inp[f"lambda_q1_{i}"] = nrm((DIFF_HEAD_DIM,), 0.1)
            inp[f"lambda_k1_{i}"] = nrm((DIFF_HEAD_DIM,), 0.1)
            inp[f"lambda_q2_{i}"] = nrm((DIFF_HEAD_DIM,), 0.1)
            inp[f"lambda_k2_{i}"] = nrm((DIFF_HEAD_DIM,), 0.1)
            inp[f"subln_{i}"] = gain(2 * DIFF_HEAD_DIM)
        else:
            inp[f"sinks_{i}"] = nrm((SWA_Q_HEADS,), 0.5)
        inp[f"w_out_{i}"] = nrm((GATE_WIDTH, D_MODEL), GATE_WIDTH ** -0.5)
    return inp


def reference(x, mem, positions,
              norm_pre_0, norm_post_0, norm_mem_0, w_in_0, w_mem_kv_0, conv_w_0, w_out_0,
              norm_pre_1, norm_post_1, norm_mem_1, w_in_1, w_mem_kv_1,
              lambda_q1_1, lambda_k1_1, lambda_q2_1, lambda_k2_1, subln_1, w_out_1,
              norm_pre_2, norm_post_2, norm_mem_2, w_in_2, w_mem_kv_2, sinks_2, w_out_2,
              norm_pre_3, norm_post_3, norm_mem_3, w_in_3, w_mem_kv_3, conv_w_3, w_out_3):
    layers = [
        dict(pre=norm_pre_0, post=norm_post_0, mem_norm=norm_mem_0, w_in=w_in_0,
             w_mem_kv=w_mem_kv_0, w_out=w_out_0, conv_w=conv_w_0),
        dict(pre=norm_pre_1, post=norm_post_1, mem_norm=norm_mem_1, w_in=w_in_1,
             w_mem_kv=w_mem_kv_1, w_out=w_out_1, lq1=lambda_q1_1, lk1=lambda_k1_1,
             lq2=lambda_q2_1, lk2=lambda_k2_1, subln=subln_1),
        dict(pre=norm_pre_2, post=norm_post_2, mem_norm=norm_mem_2, w_in=w_in_2,
             w_mem_kv=w_mem_kv_2, w_out=w_out_2, sinks=sinks_2),
        dict(pre=norm_pre_3, post=norm_post_3, mem_norm=norm_mem_3, w_in=w_in_3,
             w_mem_kv=w_mem_kv_3, w_out=w_out_3, conv_w=conv_w_3),
    ]
    b, s = x.shape[:2]
    diff_slopes = alibi_slopes(DIFF_HEADS)
    swa_slopes = alibi_slopes(SWA_Q_HEADS)
    for i in range(DEPTH):
        p = layers[i]
        kind = i % N_MIXERS
        h = rms_norm(x, p["pre"])
        proj = jnp.einsum('bsd,de->bse', h, p["w_in"])
        mem_n = rms_norm(mem, p["mem_norm"])
        if kind == 0:
            bg, cg, u, q_mem, gate = split_cols(proj, CONV_COLS)
            mix = short_conv_mixer(bg, cg, u, p["conv_w"])
        elif kind == 1:
            q, k, v, q_mem, gate = split_cols(proj, DIFF_COLS)
            q = q.reshape(b, s, DIFF_HEADS, 2, DIFF_HEAD_DIM)
            k = k.reshape(b, s, DIFF_HEADS, 2, DIFF_HEAD_DIM)
            v = v.reshape(b, s, DIFF_HEADS, 2 * DIFF_HEAD_DIM)
            lam_init = diff_lambda_init(i)
            lam = (jnp.exp(jnp.sum(p["lq1"].astype(jnp.float32) * p["lk1"].astype(jnp.float32)))
                   - jnp.exp(jnp.sum(p["lq2"].astype(jnp.float32) * p["lk2"].astype(jnp.float32)))
                   + lam_init)
            o = diff_attention(q, k, v, positions, lam, diff_slopes)
            mix = (rms_norm(o, p["subln"]) * (1.0 - lam_init)).reshape(b, s, BRANCH)
        else:
            q, k, v, q_mem, gate = split_cols(proj, SWA_COLS)
            mix = swa_with_sinks(q, k, v, positions, p["sinks"], swa_slopes)
        mem_out = memory_attention(q_mem, mem_n, p["w_mem_kv"])
        y = jnp.concatenate([mix.astype(x.dtype), mem_out.astype(x.dtype)], axis=-1) * jax.nn.silu(gate)
        y = jnp.einsum('bse,ed->bsd', y, p["w_out"])
        x = x + rms_norm(y, p["post"])
    return x
```

```cpp
#include <hip/hip_runtime.h>
#include <hip/hip_cooperative_groups.h>
#include <cstdio>
#include <cstdint>
namespace cg = cooperative_groups;
namespace pg8 {
#define PG8_LAS __attribute__((address_space(3)))
typedef unsigned short bf16_t;
typedef short bf16x8 __attribute__((ext_vector_type(8)));
typedef float f32x4 __attribute__((ext_vector_type(4)));
typedef unsigned u32x4 __attribute__((ext_vector_type(4)));
constexpr int BM = 256, BK = 64, HALF = 128, HTB = HALF * BK * 2  , STAGE_BYTES = 8 * HTB, NXCD = 8, WGM = 8;

__host__ __device__ __forceinline__ int lds_byte(int r, int c) { const int st = (r >> 4) * 2 + (c >> 5), rr = r & 15, cc = c & 31, ob = rr * 64 + cc * 2; return st * 1024 + (ob ^ (((ob >> 9) & 1) << 5)); }
__host__ __device__ __forceinline__ void stage_rc(int b, int& R, int& C) { const int st = b / 1024, sb = b % 1024, swz = sb ^ (((sb >> 9) & 1) << 5); R = (st >> 1) * 16 + swz / 64; C = (st & 1) * 32 + (swz % 64) / 2; }
__host__ __device__ __forceinline__ int perm32(int rho) { const int n = rho >> 4, i = rho & 15; return 8 * (i >> 2) + 4 * n + (i & 3); }

struct Unit { int pm, pn; };
struct Gemm { const bf16_t* A; const bf16_t* Bt; int M, N, K; };

struct StaticOrder {
    int nM, nN, nwg, G, c;
    __host__ __device__ void init(int M, int N, int G_, int c_) { nM = M / BM; nN = N / BM; nwg = nM * nN; G = G_; c = c_; }
    __host__ __device__ bool next(int i, Unit& u) const {
        const long L = (long)i * G + c; if (L >= nwg) return false;
        int wgid = (int)L; { const int q = nwg / NXCD, r = nwg % NXCD, xcd = wgid % NXCD, off = wgid / NXCD; wgid = (xcd < r ? xcd * (q + 1) : r * (q + 1) + (xcd - r) * q) + off; }
        const int nig = WGM * nN, gid = wgid / nig, fm = gid * WGM, gsz = (nM - fm) < WGM ? (nM - fm) : WGM;
        u.pm = fm + ((wgid % nig) % gsz); u.pn = (wgid % nig) / gsz; return true;
    }
    __device__ __forceinline__ void a_ready(const Unit&) const {}
    __device__ __forceinline__ void done(const Unit&) const {}
};

__device__ __forceinline__ unsigned cvt_pk_bf16(float lo, float hi) { unsigned r; asm volatile("v_cvt_pk_bf16_f32 %0, %1, %2" : "=v"(r) : "v"(lo), "v"(hi)); return r; }
template <class Epi, class Sched, bool ALIGN_EPI = false, bool SP2 = false>
__device__ __forceinline__ void gemm_phase(PG8_LAS unsigned char* lds, const Gemm g, const Sched& S, const Epi& E) {
    int tid_ = threadIdx.x; asm volatile("" : "+v"(tid_)); const int tid = tid_, wid = __builtin_amdgcn_readfirstlane(tid >> 6), lane = tid & 63, wr = wid >> 2, wc = wid & 3, fr = lane & 15, fq = lane >> 4;
    const int K = g.K, nt = K / BK;
    unsigned voffA[2], voffB[2];
#pragma unroll
    for (int i = 0; i < 2; ++i) { int R, C; stage_rc(tid * 16 + i * 8192, R, C); const int Rb = Epi::PERM ? ((R & ~31) + perm32(R & 31)) : R;
        voffA[i] = (unsigned)(R * K + C) * 2u; voffB[i] = (unsigned)(Rb * K + C) * 2u; }
    const size_t kstep = (size_t)(BK * 2);
    const size_t hstep = (size_t)HALF * K * 2;
    const size_t tstep = 2 * hstep;
    const unsigned ldsw = (unsigned)wid * 1024u;
    const int aoff = lds_byte(wr * 64 + fr, fq * 8), boff = lds_byte(wc * 32 + fr, fq * 8);
#define PG8_SA(b, h) (((b) * 2 + (h)) * HTB)
#define PG8_SB(b, h) ((4 + (b) * 2 + (h)) * HTB)
#define PG8_STAGE(bufoff, gbase, voff) do { _Pragma("unroll") for (int _i = 0; _i < 2; ++_i) \
        __builtin_amdgcn_global_load_lds((const unsigned*)((const char*)(gbase) + (voff)[_i]), (PG8_LAS unsigned*)(lds + (bufoff) + ldsw + _i * 8192), 16, 0, 0); } while (0)
#define PG8_LDA(dst, b, h) do { _Pragma("unroll") for (int m = 0; m < 4; ++m) _Pragma("unroll") for (int k = 0; k < 2; ++k) dst[m][k] = *(const PG8_LAS bf16x8*)(lds + PG8_SA(b, h) + aoff + m * 2048 + k * 1024); } while (0)
#define PG8_LDB(dst, b, h) do { _Pragma("unroll") for (int n = 0; n < 2; ++n) _Pragma("unroll") for (int k = 0; k < 2; ++k) dst[n][k] = *(const PG8_LAS bf16x8*)(lds + PG8_SB(b, h) + boff + n * 2048 + k * 1024); } while (0)
#define PG8_MMA(ai, bj, At, Bt) do { __builtin_amdgcn_s_setprio(1); _Pragma("unroll") for (int m = 0; m < 4; ++m) _Pragma("unroll") for (int n = 0; n < 2; ++n) _Pragma("unroll") for (int k = 0; k < 2; ++k) \
        acc[ai][bj][m][n] = __builtin_amdgcn_mfma_f32_16x16x32_bf16(Bt[n][k], At[m][k], acc[ai][bj][m][n], 0, 0, 0); __builtin_amdgcn_s_setprio(0); } while (0)
#define PG8_WAIT_V(n) asm volatile("s_waitcnt vmcnt(" #n ")" ::: "memory")
#define PG8_WAIT_L(n) asm volatile("s_waitcnt lgkmcnt(" #n ")" ::: "memory")
#define PG8_BAR __builtin_amdgcn_s_barrier()
#define PG8_SCHED __builtin_amdgcn_sched_barrier(0)
    Unit cur, nxt; int ui = 0;
    if (!S.next(0, cur)) return;
    f32x4 acc[2][2][4][2];
#pragma unroll
    for (int a = 0; a < 2; ++a)
#pragma unroll
        for (int b = 0; b < 2; ++b)
#pragma unroll
            for (int m = 0; m < 4; ++m)
#pragma unroll
                for (int n = 0; n < 2; ++n) acc[a][b][m][n] = (f32x4){0.f, 0.f, 0.f, 0.f};
    bf16x8 At[4][2], B0[2][2], B1[2][2];
    const char* cA = (const char*)g.A + (size_t)cur.pm * tstep; const char* cB = (const char*)g.Bt + (size_t)cur.pn * tstep;
    S.a_ready(cur);
    if constexpr (SP2) {
        PG8_STAGE(PG8_SB(0, 0), cB, voffB); PG8_STAGE(PG8_SB(0, 1), cB + hstep, voffB); PG8_STAGE(PG8_SA(0, 0), cA, voffA); PG8_STAGE(PG8_SA(0, 1), cA + hstep, voffA);
        if (wr == 1) PG8_BAR;
        PG8_WAIT_V(2); PG8_BAR;
        PG8_STAGE(PG8_SB(1, 0), cB + kstep, voffB); PG8_STAGE(PG8_SA(1, 0), cA + kstep, voffA); PG8_STAGE(PG8_SB(1, 1), cB + hstep + kstep, voffB);
        PG8_WAIT_V(6); PG8_BAR;
    } else {
        PG8_STAGE(PG8_SB(0, 0), cB, voffB); PG8_STAGE(PG8_SA(0, 0), cA, voffA); PG8_STAGE(PG8_SB(0, 1), cB + hstep, voffB); PG8_STAGE(PG8_SA(0, 1), cA + hstep, voffA);
        if (wr == 1) PG8_BAR;
        PG8_WAIT_V(4); PG8_BAR;
        PG8_STAGE(PG8_SB(1, 0), cB + kstep, voffB); PG8_STAGE(PG8_SA(1, 0), cA + kstep, voffA); PG8_STAGE(PG8_SB(1, 1), cB + hstep + kstep, voffB);
        PG8_WAIT_V(6); PG8_BAR;
    }
    for (;;) {
        const bool has_next = S.next(ui + 1, nxt);
        const char* nA = has_next ? (const char*)g.A + (size_t)nxt.pm * tstep : cA; const char* nB = has_next ? (const char*)g.Bt + (size_t)nxt.pn * tstep : cB;
        for (int t = 0; t < nt; t += 2) {
            const bool last = (t == nt - 2);
            const char* a1 = cA + (size_t)(t + 1) * kstep;
            const char* a2 = last ? nA : cA + (size_t)(t + 2) * kstep; const char* b2 = last ? nB : cB + (size_t)(t + 2) * kstep;
            const char* a3 = a2 + kstep; const char* b3 = b2 + kstep;
            if (last && has_next) S.a_ready(nxt);
            if constexpr (SP2) {
            PG8_LDB(B0, 0, 0); PG8_LDB(B1, 0, 1); PG8_SCHED; PG8_LDA(At, 0, 0); PG8_STAGE(PG8_SA(1, 1), a1 + hstep, voffA);
            PG8_WAIT_V(8); PG8_WAIT_L(0); PG8_BAR; PG8_MMA(0, 0, At, B0); PG8_MMA(0, 1, At, B1); PG8_BAR; PG8_SCHED;
            PG8_LDA(At, 0, 1); PG8_STAGE(PG8_SB(0, 0), b2, voffB); PG8_STAGE(PG8_SB(0, 1), b2 + hstep, voffB); PG8_STAGE(PG8_SA(0, 0), a2, voffA);
            PG8_WAIT_V(8); PG8_WAIT_L(0); PG8_BAR; PG8_MMA(1, 0, At, B0); PG8_MMA(1, 1, At, B1); PG8_BAR; PG8_SCHED;
            PG8_LDB(B0, 1, 0); PG8_LDB(B1, 1, 1); PG8_SCHED; PG8_LDA(At, 1, 0); PG8_STAGE(PG8_SA(0, 1), a2 + hstep, voffA);
            PG8_WAIT_V(8); PG8_WAIT_L(0); PG8_BAR; PG8_MMA(0, 0, At, B0); PG8_MMA(0, 1, At, B1); PG8_BAR; PG8_SCHED;
            PG8_LDA(At, 1, 1); PG8_STAGE(PG8_SB(1, 0), b3, voffB); PG8_STAGE(PG8_SB(1, 1), b3 + hstep, voffB); PG8_STAGE(PG8_SA(1, 0), a3, voffA);
            PG8_WAIT_V(8); PG8_WAIT_L(0); PG8_BAR; PG8_MMA(1, 0, At, B0); PG8_MMA(1, 1, At, B1); PG8_BAR; PG8_SCHED;
            } else {
            PG8_LDB(B0, 0, 0); PG8_SCHED; PG8_LDA(At, 0, 0); PG8_STAGE(PG8_SA(1, 1), a1 + hstep, voffA);
            PG8_WAIT_L(8); PG8_BAR; PG8_WAIT_L(0); PG8_MMA(0, 0, At, B0); PG8_BAR; PG8_SCHED;
            PG8_LDB(B1, 0, 1); PG8_STAGE(PG8_SB(0, 0), b2, voffB);
            PG8_BAR; PG8_WAIT_L(0); PG8_MMA(0, 1, At, B1); PG8_BAR;
            PG8_LDA(At, 0, 1); PG8_STAGE(PG8_SA(0, 0), a2, voffA);
            PG8_BAR; PG8_WAIT_L(0); PG8_MMA(1, 0, At, B0); PG8_BAR; PG8_SCHED;
            PG8_STAGE(PG8_SB(0, 1), b2 + hstep, voffB);
            PG8_WAIT_V(6); PG8_BAR; PG8_MMA(1, 1, At, B1); PG8_BAR;
            PG8_LDB(B0, 1, 0); PG8_SCHED; PG8_LDA(At, 1, 0); PG8_STAGE(PG8_SA(0, 1), a2 + hstep, voffA);
            PG8_WAIT_L(8); PG8_BAR; PG8_WAIT_L(0); PG8_MMA(0, 0, At, B0); PG8_BAR; PG8_SCHED;
            PG8_LDB(B1, 1, 1); PG8_STAGE(PG8_SB(1, 0), b3, voffB);
            PG8_BAR; PG8_WAIT_L(0); PG8_MMA(0, 1, At, B1); PG8_BAR;
            PG8_LDA(At, 1, 1); PG8_STAGE(PG8_SA(1, 0), a3, voffA);
            PG8_BAR; PG8_WAIT_L(0); PG8_MMA(1, 0, At, B0); PG8_BAR; PG8_SCHED;
            PG8_STAGE(PG8_SB(1, 1), b3 + hstep, voffB);
            PG8_WAIT_V(6); PG8_BAR; PG8_MMA(1, 1, At, B1); PG8_BAR;
            }
        }
        if constexpr (ALIGN_EPI) { if (wr == 0) PG8_BAR; }
        if constexpr (!Epi::AFTER_DRAIN) { E(acc, cur, wr, wc, fr, fq); S.done(cur); }
        if (!has_next) break;
#pragma unroll
        for (int a = 0; a < 2; ++a)
#pragma unroll
            for (int b = 0; b < 2; ++b)
#pragma unroll
                for (int m = 0; m < 4; ++m)
#pragma unroll
                    for (int n = 0; n < 2; ++n) acc[a][b][m][n] = (f32x4){0.f, 0.f, 0.f, 0.f};
        cur = nxt; cA = nA; cB = nB; ++ui;
        if constexpr (ALIGN_EPI) { if (wr == 1) PG8_BAR; }
    }
    PG8_WAIT_V(0);
    if constexpr (!ALIGN_EPI) { if (wr == 0) PG8_BAR; }
    PG8_BAR;
    if constexpr (Epi::AFTER_DRAIN) { E.fused(acc, cur, wr, wc, fr, fq, lds, wid, lane); S.done(cur); }
#undef PG8_SA
#undef PG8_SB
#undef PG8_STAGE
#undef PG8_LDA
#undef PG8_LDB
#undef PG8_MMA
#undef PG8_WAIT_V
#undef PG8_WAIT_L
#undef PG8_BAR
#undef PG8_SCHED
}
}
#define GAS __attribute__((address_space(1)))
#define LAS __attribute__((address_space(3)))
typedef unsigned short bf16;
typedef unsigned v4u __attribute__((ext_vector_type(4)));
typedef float f32x4 __attribute__((ext_vector_type(4)));
typedef short bf16x8 __attribute__((ext_vector_type(8)));
typedef GAS unsigned gu32;
typedef GAS unsigned long long gu64;
#define RLX_AGENT __ATOMIC_RELAXED, __HIP_MEMORY_SCOPE_AGENT
#define LDS_WAIT() asm volatile("s_waitcnt lgkmcnt(0)" ::: "memory")
#define VM_WAIT() asm volatile("s_waitcnt vmcnt(0)" ::: "memory")
__device__ __forceinline__ unsigned long long rt() { return __builtin_amdgcn_s_memrealtime(); }
__device__ __forceinline__ unsigned f2bf(float f) { unsigned u = __builtin_bit_cast(unsigned, f); return (u + 0x7fffu + ((u >> 16) & 1u)) >> 16; }
__device__ __forceinline__ unsigned pk2(float lo, float hi) { return f2bf(lo) | (f2bf(hi) << 16); }

#define XB_TMO      128
#define XB_XCNT(j)  (256  + 64 * (j))
#define XB_XSUB(j)  (1280 + 64 * (j))
#define XB_XGEN(j)  (2304 + 64 * (j))
#define XB_TOP      3328
#define XB_TOPGEN   3392
#define XCD_BAR_WORDS 3456
#define XB_SPIN_CAP (1u << 18)

__device__ __forceinline__ unsigned xb_ld(unsigned* p)              { return __hip_atomic_load(p, __ATOMIC_RELAXED, __HIP_MEMORY_SCOPE_AGENT); }
__device__ __forceinline__ unsigned xb_add(unsigned* p, unsigned v) { return __hip_atomic_fetch_add(p, v, __ATOMIC_RELAXED, __HIP_MEMORY_SCOPE_AGENT); }
__device__ __forceinline__ unsigned xb_xcc_id() { return (unsigned)__builtin_amdgcn_s_getreg((3 << 11) | 20) & 0xFu; }
#define XB_SPIN(cond, bar) do { unsigned _sp = 0; while (cond) { __builtin_amdgcn_s_sleep(1); \
    if ((++_sp & 255u) == 0u) { if (xb_ld(&(bar)[XB_TMO])) break; if (_sp > XB_SPIN_CAP) { atomicAdd(&(bar)[XB_TMO], 1u); break; } } } } while (0)

struct XcdBarrier {
    unsigned* bar; unsigned x;
    volatile LAS unsigned* st;
};

__device__ __forceinline__ XcdBarrier xcd_barrier_post(unsigned* bar, volatile LAS unsigned* st) {
    XcdBarrier b; b.bar = bar; b.x = xb_xcc_id(); b.st = st;
    if (threadIdx.x == 0) (void)xb_add(&bar[XB_XCNT(b.x)], 1u);
    return b;
}
__device__ __forceinline__ void xcd_barrier_complete(unsigned* bar, unsigned x, unsigned& nloc, unsigned& nx) {
    const unsigned G = gridDim.x * gridDim.y * gridDim.z;
    unsigned sum, cnt, mine, sp = 0u;
    for (;;) {
        sum = 0u; cnt = 0u; mine = 0u;
#pragma unroll
        for (unsigned j = 0; j < 16; ++j) { const unsigned c = xb_ld(&bar[XB_XCNT(j)]); sum += c; cnt += (c > 0u) ? 1u : 0u; mine = (j == x) ? c : mine; }
        if (sum == G) break;
        __builtin_amdgcn_s_sleep(1);
        if ((++sp & 255u) == 0u) { if (xb_ld(&bar[XB_TMO])) break; if (sp > XB_SPIN_CAP) { atomicAdd(&bar[XB_TMO], 1u); break; } }
    }
    nloc = mine > 0u ? mine : 1u; nx = cnt > 0u ? cnt : 1u;
}

__device__ __forceinline__ void xcd_barrier(const XcdBarrier& b) {
    asm volatile("s_waitcnt vmcnt(0)" ::: "memory");
    __syncthreads();
    if (threadIdx.x == 0) {
        unsigned* bar = b.bar;
        __builtin_amdgcn_s_waitcnt(0);
        unsigned nloc = b.st[0], nx = b.st[1];
        if (nloc == 0u) { xcd_barrier_complete(bar, b.x, nloc, nx); b.st[0] = nloc; b.st[1] = nx; }
        const unsigned old = xb_add(&bar[XB_XSUB(b.x)], 1u);
        const unsigned gen = old / nloc;
        if (old + 1u == (gen + 1u) * nloc) {
            __builtin_amdgcn_fence(__ATOMIC_RELEASE, "agent");
            asm volatile("s_waitcnt vmcnt(0)" ::: "memory");
            const unsigned og = xb_add(&bar[XB_TOP], 1u);
            const unsigned tg = og / nx;
            if (og + 1u == (tg + 1u) * nx) xb_add(&bar[XB_TOPGEN], 1u);
            else XB_SPIN(xb_ld(&bar[XB_TOPGEN]) == tg, bar);
            __builtin_amdgcn_fence(__ATOMIC_ACQUIRE, "agent");
            xb_add(&bar[XB_XGEN(b.x)], 1u);
            asm volatile("s_waitcnt vmcnt(0)" ::: "memory");
        } else {
            XB_SPIN(xb_ld(&bar[XB_XGEN(b.x)]) == gen, bar);
            __builtin_amdgcn_fence(__ATOMIC_ACQUIRE, "agent");
            asm volatile("s_waitcnt vmcnt(0)" ::: "memory");
        }
    }
    __syncthreads();
}

constexpr int M = 16384, D = 1024, BR = 2048, GWID = 2304, QMW = 256;
constexpr float EPS = 1e-6f, LOG2E = 1.4426950408889634f, C2 = 0.125f * 1.4426950408889634f, NEGBIG = -1e30f;
constexpr float LAM_INIT = 0.35550907f;
typedef float f32x16 __attribute__((ext_vector_type(16)));
typedef unsigned u32x2 __attribute__((ext_vector_type(2)));
typedef int i32x4 __attribute__((ext_vector_type(4)));
typedef short s16x4 __attribute__((ext_vector_type(4)));

constexpr size_t MiB = 1u << 20, KiB = 1024;
constexpr size_t WS_BAR = 0;
constexpr size_t WS_RSTD = 64 * KiB, WS_SS = 128 * KiB, WS_KMEM = 192 * KiB, WS_VMEMT = 320 * KiB, WS_MEMN = 448 * KiB, WS_MISC = 960 * KiB;
constexpr size_t WS_WMEM = 1 * MiB, WS_WIN = 2 * MiB, WS_WOUT = 19 * MiB, WS_XB = 24 * MiB, WS_QM = 56 * MiB;
constexpr size_t WS_RQ = 64 * MiB, WS_RK = 128 * MiB, WS_RV = 192 * MiB, WS_END = 256 * MiB;
constexpr size_t WS_SGY = 128 * MiB;
constexpr size_t WS_KS = 200 * MiB, WS_VTS = 208 * MiB;
constexpr int LDS_BYTES = 147456, MISC_OFF = LDS_BYTES - 128;
constexpr int NWAVES = 8;

__device__ __forceinline__ float silu_f(float x) { return x * __builtin_amdgcn_rcpf(1.0f + __builtin_amdgcn_exp2f(-x * LOG2E)); }
__device__ __forceinline__ unsigned pkbf(float lo, float hi) { return pg8::cvt_pk_bf16(lo, hi); }
__device__ __forceinline__ float bf_lo(unsigned u) { return __uint_as_float(u << 16); }
__device__ __forceinline__ float bf_hi(unsigned u) { return __uint_as_float(u & 0xffff0000u); }

enum { EM_CONV = 0, EM_DIFF1, EM_VT, EM_GATE, EM_SWA, EM_PLAIN, EM_OUT };
struct Epi {
    static constexpr bool PERM = true, AFTER_DRAIN = false;
    int mode; int ldc; const float* rstd; unsigned char* ws; bf16* o0; float* ss;
    __device__ __forceinline__ void operator()(const pg8::f32x4 (&acc)[2][2][4][2], const pg8::Unit& u, int wr, int wc, int fr, int fq) const {
        using pg8::f32x4; typedef unsigned u32x4v __attribute__((ext_vector_type(4)));
        const int row0 = u.pm * 256 + wr * 64 + fr, tc8 = wc * 32 + fq * 8;
        bf16* RQ = (bf16*)(ws + WS_RQ); bf16* RK = (bf16*)(ws + WS_RK); bf16* QM = (bf16*)(ws + WS_QM); bf16* SGY = (bf16*)(ws + WS_SGY); bf16* KS = (bf16*)(ws + WS_KS);
#define ST8(ptr, a, b) do { u32x4v w_; w_.x = pkbf((a)[0], (a)[1]); w_.y = pkbf((a)[2], (a)[3]); w_.z = pkbf((b)[0], (b)[1]); w_.w = pkbf((b)[2], (b)[3]); *(u32x4v*)(ptr) = w_; } while (0)
        if (mode == EM_CONV) {
            if (u.pn < 32) {
                const int col = u.pn * 64 + wc * 16 + fq * 4;
#pragma unroll
                for (int ai = 0; ai < 2; ++ai)
#pragma unroll
                    for (int m = 0; m < 4; ++m) { const int row = row0 + ai * 128 + m * 16; const float rs = rstd[row];
                        const f32x4 bg = acc[ai][0][m][0] * rs, cgv = acc[ai][0][m][1] * rs, uu = acc[ai][1][m][0] * rs, gt = acc[ai][1][m][1] * rs;
                        const f32x4 z = cgv * uu; f32x4 b; b[0] = bg[0] * silu_f(gt[0]); b[1] = bg[1] * silu_f(gt[1]); b[2] = bg[2] * silu_f(gt[2]); b[3] = bg[3] * silu_f(gt[3]);
                        u32x2 zz; zz.x = pkbf(z[0], z[1]); zz.y = pkbf(z[2], z[3]); *(u32x2*)(RQ + (size_t)row * BR + col) = zz;
                        u32x2 bb; bb.x = pkbf(b[0], b[1]); bb.y = pkbf(b[2], b[3]); *(u32x2*)(SGY + (size_t)row * GWID + col) = bb; }
            } else {
                const int col = (u.pn - 32) * 128 + tc8;
#pragma unroll
                for (int ai = 0; ai < 2; ++ai)
#pragma unroll
                    for (int m = 0; m < 4; ++m) { const int row = row0 + ai * 128 + m * 16; const float rs = rstd[row]; const float rq = rs * C2;
                        const f32x4 q0 = acc[ai][0][m][0] * rq, q1 = acc[ai][0][m][1] * rq; ST8(QM + (size_t)row * QMW + col, q0, q1);
                        f32x4 g0 = acc[ai][1][m][0] * rs, g1 = acc[ai][1][m][1] * rs;
#pragma unroll
                        for (int j = 0; j < 4; ++j) { g0[j] = silu_f(g0[j]); g1[j] = silu_f(g1[j]); }
                        ST8(SGY + (size_t)row * GWID + BR + col, g0, g1); }
            }
        } else if (mode == EM_DIFF1 || mode == EM_SWA) {
            bf16* dst; int pitch; float sc = 1.f; int act = 0; const int pn = u.pn;
            if (pn < 8) { dst = RQ + pn * 256; pitch = BR; sc = C2; }
            else if (mode == EM_DIFF1) { if (pn < 16) { dst = RK + (pn - 8) * 256; pitch = BR; } else { dst = QM; pitch = QMW; sc = C2; } }
            else { if (pn == 8) { dst = KS; pitch = 256; } else if (pn == 9) { dst = QM; pitch = QMW; sc = C2; } else { dst = SGY + (pn - 10) * 256; pitch = GWID; act = 1; } }
#pragma unroll
            for (int ai = 0; ai < 2; ++ai)
#pragma unroll
                for (int m = 0; m < 4; ++m) { const int row = row0 + ai * 128 + m * 16; const float rs = rstd[row] * sc;
#pragma unroll
                    for (int bj = 0; bj < 2; ++bj) { f32x4 v0 = acc[ai][bj][m][0] * rs, v1 = acc[ai][bj][m][1] * rs;
                        if (act) {
#pragma unroll
                            for (int j = 0; j < 4; ++j) { v0[j] = silu_f(v0[j]); v1[j] = silu_f(v1[j]); } }
                        ST8(dst + (size_t)row * pitch + bj * 128 + tc8, v0, v1); } }
        } else if (mode == EM_VT) {
#pragma unroll
            for (int bj = 0; bj < 2; ++bj) { const int col = u.pn * 256 + bj * 128 + tc8; f32x4 r0 = {1.f, 1.f, 1.f, 1.f}, r1 = r0;
                if (rstd) { r0 = *(const f32x4*)(rstd + col); r1 = *(const f32x4*)(rstd + col + 4); }
                const int p0 = col - (fq & 1) * 8 + (fq & 1) * 4;
#pragma unroll
                for (int ai = 0; ai < 2; ++ai)
#pragma unroll
                    for (int m = 0; m < 4; ++m) { const int row = row0 + ai * 128 + m * 16; const f32x4 v0 = acc[ai][bj][m][0] * r0, v1 = acc[ai][bj][m][1] * r1;
                        u32x2 a_, b_; a_.x = pkbf(v0[0], v0[1]); a_.y = pkbf(v0[2], v0[3]); b_.x = pkbf(v1[0], v1[1]); b_.y = pkbf(v1[2], v1[3]);
                        *(u32x2*)(o0 + (size_t)row * ldc + p0) = a_; *(u32x2*)(o0 + (size_t)row * ldc + p0 + 8) = b_; } }
        } else if (mode == EM_GATE) {
            const int pn = u.pn; const bf16* src; int sp; if (pn < 8) { src = RQ + pn * 256; sp = BR; } else { src = QM; sp = QMW; }
            bf16* dst = SGY + pn * 256;
#pragma unroll
            for (int ai = 0; ai < 2; ++ai)
#pragma unroll
                for (int m = 0; m < 4; ++m) { const int row = row0 + ai * 128 + m * 16; const float rs = rstd[row];
#pragma unroll
                    for (int bj = 0; bj < 2; ++bj) { f32x4 v0 = acc[ai][bj][m][0] * rs, v1 = acc[ai][bj][m][1] * rs;
                        const u32x4v mx = *(const u32x4v*)(src + (size_t)row * sp + bj * 128 + tc8);
                        v0[0] = silu_f(v0[0]) * bf_lo(mx.x); v0[1] = silu_f(v0[1]) * bf_hi(mx.x); v0[2] = silu_f(v0[2]) * bf_lo(mx.y); v0[3] = silu_f(v0[3]) * bf_hi(mx.y);
                        v1[0] = silu_f(v1[0]) * bf_lo(mx.z); v1[1] = silu_f(v1[1]) * bf_hi(mx.z); v1[2] = silu_f(v1[2]) * bf_lo(mx.w); v1[3] = silu_f(v1[3]) * bf_hi(mx.w);
                        ST8(dst + (size_t)row * GWID + bj * 128 + tc8, v0, v1); } }
        } else if (mode == EM_PLAIN) {
#pragma unroll
            for (int ai = 0; ai < 2; ++ai)
#pragma unroll
                for (int m = 0; m < 4; ++m) { const int row = row0 + ai * 128 + m * 16;
#pragma unroll
                    for (int bj = 0; bj < 2; ++bj) ST8(o0 + (size_t)row * ldc + u.pn * 256 + bj * 128 + tc8, acc[ai][bj][m][0], acc[ai][bj][m][1]); }
        } else {
            float* YO = (float*)(ws + WS_RQ);
#pragma unroll
            for (int ai = 0; ai < 2; ++ai)
#pragma unroll
                for (int m = 0; m < 4; ++m) { const int row = row0 + ai * 128 + m * 16; float q = 0.f;
#pragma unroll
                    for (int bj = 0; bj < 2; ++bj) { const f32x4 v0 = acc[ai][bj][m][0], v1 = acc[ai][bj][m][1];
                        float* p = YO + (size_t)row * D + u.pn * 256 + bj * 128 + tc8; *(f32x4*)p = v0; *(f32x4*)(p + 4) = v1;
                        q += (v0[0] * v0[0] + v0[1] * v0[1]) + (v0[2] * v0[2] + v0[3] * v0[3]) + (v1[0] * v1[0] + v1[1] * v1[1]) + (v1[2] * v1[2] + v1[3] * v1[3]); }
                    q += __shfl_xor(q, 16); q += __shfl_xor(q, 32);
                    if (fq == 0) ss[(size_t)row * 16 + u.pn * 4 + wc] = q; }
        }
#undef ST8
    }
};
struct OneUnit { int has;
    __device__ __forceinline__ bool next(int i, pg8::Unit& u) const { if (i > 0 || !has) return false; u.pm = 0; u.pn = 0; return true; }
    __device__ __forceinline__ void a_ready(const pg8::Unit&) const {}
    __device__ __forceinline__ void done(const pg8::Unit&) const {} };

struct Args { const void* in[35]; float* out; unsigned char* ws; int ph_lo, ph_hi; };
struct Frame { LAS unsigned char* lds; int tid, lane, wave, G, bx, gw, NGW; unsigned char* ws; };
__device__ __forceinline__ void frame_refresh(Frame& F) { int t = threadIdx.x; asm volatile("" : "+v"(t)); F.tid = t; F.lane = t & 63; F.wave = __builtin_amdgcn_readfirstlane(t >> 6); F.gw = F.bx * NWAVES + F.wave; }

__device__ __forceinline__ float wave_sum(float v) {
#pragma unroll
    for (int o = 1; o < 64; o <<= 1) v += __shfl_xor(v, o);
    return v;
}
__device__ __forceinline__ int win_srccol(int kind, int n) {
    if (kind == 0) {
        const int pn = n >> 8, tc = n & 255;
        if (pn < 32) { const int bj = tc >> 7, wc = (tc >> 5) & 3, i = tc & 31, fq = i >> 3, nn = (i >> 2) & 1, j = i & 3, s = 2 * bj + nn;
            const int base = (s == 0) ? 0 : (s == 1) ? 2048 : (s == 2) ? 4096 : 6400; return base + pn * 64 + wc * 16 + fq * 4 + j; }
        const int t = pn - 32, bj = tc >> 7, c = tc & 127; return (bj == 0 ? 6144 : 6400 + 2048) + t * 128 + c;
    } else if (kind == 1) {
        if (n < 4096) return n; if (n < 4352) return 6144 + (n - 4096); if (n < 6400) return 4096 + (n - 4352); return n;
    } else {
        if (n < 2304) return n; if (n < 2560) return 2560 + (n - 2304); if (n < 4864) return 2816 + (n - 2560); return 2304 + (n - 4864);
    }
}
__device__ __forceinline__ void transpose_item(const float* W, int K, int Nsrc, const float* gain, int mapmode, bf16* WT, LAS float* scr, int item, int nblk, int lane) {
    const int kb = item / nblk, nb = item % nblk, k0 = 64 * kb, n0 = 32 * nb;
    const int nd = n0 + (lane & 31); const int sc = (mapmode < 0) ? nd : win_srccol(mapmode, nd);
#pragma unroll 8
    for (int i = 0; i < 32; ++i) { const int kk = 2 * i + (lane >> 5); float v = W[(size_t)(k0 + kk) * Nsrc + sc]; if (gain) v *= gain[k0 + kk]; scr[kk * 33 + (lane & 31)] = v; }
    LDS_WAIT(); asm volatile("" ::: "memory");
    const int c = lane & 7;
#pragma unroll
    for (int j = 0; j < 4; ++j) { const int n = (lane >> 3) + 8 * j; const LAS float* s = scr + (8 * c) * 33 + n;
        v4u o; o.x = pk2(s[0 * 33], s[1 * 33]); o.y = pk2(s[2 * 33], s[3 * 33]); o.z = pk2(s[4 * 33], s[5 * 33]); o.w = pk2(s[6 * 33], s[7 * 33]);
        *(GAS v4u*)(WT + (size_t)(n0 + n) * K + k0 + 8 * c) = o; }
    LDS_WAIT(); asm volatile("" ::: "memory");
}

__device__ __forceinline__ void prep_phase(Frame& F, const Args& a, int L) {
    float* rstd = (float*)(F.ws + WS_RSTD); float* ss = (float*)(F.ws + WS_QM); bf16* XB = (bf16*)(F.ws + WS_XB); const float* YO = (const float*)(F.ws + WS_RQ);
    const int base_prev = (L == 1) ? 3 : (L == 2) ? 10 : (L == 3) ? 21 : 28;
    const float* gpost = (L > 0) ? (const float*)a.in[base_prev + 1] : nullptr;
    const float* xin = (L <= 1) ? (const float*)a.in[0] : a.out;
    for (int m = F.gw; m < M; m += F.NGW) {
        const GAS f32x4* xr = (const GAS f32x4*)(xin + (size_t)m * D) + F.lane;
        f32x4 v[4];
#pragma unroll
        for (int j = 0; j < 4; ++j) v[j] = xr[64 * j];
        if (L > 0) {
            float ssum = 0.f; { const f32x4* sp = (const f32x4*)(ss + (size_t)m * 16); const f32x4 a0 = sp[0], a1 = sp[1], a2 = sp[2], a3 = sp[3];
                ssum = ((a0.x + a0.y) + (a0.z + a0.w)) + ((a1.x + a1.y) + (a1.z + a1.w)) + ((a2.x + a2.y) + (a2.z + a2.w)) + ((a3.x + a3.y) + (a3.z + a3.w)); }
            const float r = 1.0f / sqrtf(ssum * (1.0f / D) + EPS);
            const GAS f32x4* yr = (const GAS f32x4*)(YO + (size_t)m * D) + F.lane; const GAS f32x4* gp = (const GAS f32x4*)gpost + F.lane;
#pragma unroll
            for (int j = 0; j < 4; ++j) { const f32x4 y = yr[64 * j], g = gp[64 * j]; v[j] = v[j] + y * g * r; }
            GAS f32x4* xo = (GAS f32x4*)(a.out + (size_t)m * D) + F.lane;
#pragma unroll
            for (int j = 0; j < 4; ++j) xo[64 * j] = v[j];
        }
        if (L < 4) {
            float s2 = 0.f;
#pragma unroll
            for (int j = 0; j < 4; ++j) s2 += (v[j].x * v[j].x + v[j].y * v[j].y) + (v[j].z * v[j].z + v[j].w * v[j].w);
            s2 = wave_sum(s2);
            GAS unsigned long long* o8 = (GAS unsigned long long*)(XB + (size_t)m * D) + F.lane;
#pragma unroll
            for (int j = 0; j < 4; ++j) o8[64 * j] = (unsigned long long)pk2(v[j].x, v[j].y) | ((unsigned long long)pk2(v[j].z, v[j].w) << 32);
            if (F.lane == 0) rstd[m] = 1.0f / sqrtf(s2 * (1.0f / D) + EPS);
        }
    }
    if (L >= 4) return;
    const int base = (L == 0) ? 3 : (L == 1) ? 10 : (L == 2) ? 21 : 28; const int kind = (L == 3) ? 0 : L;
    const float* gpre = (const float*)a.in[base]; const float* gmem = (const float*)a.in[base + 2];
    const float* w_in = (const float*)a.in[base + 3]; const float* w_mem = (const float*)a.in[base + 4];
    const float* w_out = (const float*)a.in[(L == 0) ? 9 : (L == 1) ? 20 : (L == 2) ? 27 : 34];
    const int NIN = (kind == 2) ? 5120 : 8704;
    bf16* MEMN = (bf16*)(F.ws + WS_MEMN);
    for (int m = F.gw; m < 256; m += F.NGW) {
        const GAS f32x4* xr = (const GAS f32x4*)((const float*)a.in[1] + (size_t)m * D) + F.lane; const GAS f32x4* gp = (const GAS f32x4*)gmem + F.lane;
        f32x4 v[4]; float s2 = 0.f;
#pragma unroll
        for (int j = 0; j < 4; ++j) { v[j] = xr[64 * j]; s2 += (v[j].x * v[j].x + v[j].y * v[j].y) + (v[j].z * v[j].z + v[j].w * v[j].w); }
        const float r = 1.0f / sqrtf(wave_sum(s2) * (1.0f / D) + EPS);
        GAS unsigned long long* o8 = (GAS unsigned long long*)(MEMN + (size_t)m * D) + F.lane;
#pragma unroll
        for (int j = 0; j < 4; ++j) { const f32x4 g = gp[64 * j]; const f32x4 t = v[j] * g * r; o8[64 * j] = (unsigned long long)pk2(t.x, t.y) | ((unsigned long long)pk2(t.z, t.w) << 32); }
    }
    LAS float* scr = (LAS float*)(F.lds + F.wave * 16384);
    const int I_IN = (D / 64) * (NIN / 32), I_OUT = (GWID / 64) * (D / 32), I_MEM = (D / 64) * (512 / 32);
    for (int it = F.gw; it < I_IN + I_OUT + I_MEM; it += F.NGW) {
        int r = it;
        if (r < I_IN) { transpose_item(w_in, D, NIN, gpre, kind, (bf16*)(F.ws + WS_WIN), scr, r, NIN / 32, F.lane); continue; } r -= I_IN;
        if (r < I_OUT) { transpose_item(w_out, GWID, D, nullptr, -1, (bf16*)(F.ws + WS_WOUT), scr, r, D / 32, F.lane); continue; } r -= I_OUT;
        transpose_item(w_mem, D, 512, nullptr, -1, (bf16*)(F.ws + WS_WMEM), scr, r, 512 / 32, F.lane);
    }
}

__device__ __forceinline__ void conv_phase(Frame& F, const float* convw) {
    const bf16* Z = (const bf16*)(F.ws + WS_RQ); bf16* SGY = (bf16*)(F.ws + WS_SGY);
    const int nthreads = F.G * 512; const int gt = F.bx * 512 + F.tid;
    for (int task = gt; task < 256 * 512; task += nthreads) {
        const int cc = (task & 255) * 8, t0 = (task >> 8) * 32;
        float w0[8], w1[8], w2[8];
#pragma unroll
        for (int j = 0; j < 8; ++j) { w0[j] = convw[cc + j]; w1[j] = convw[BR + cc + j]; w2[j] = convw[2 * BR + cc + j]; }
        float za[8], zb[8];
        if (t0 >= 2) { const v4u a = *(const v4u*)(Z + (size_t)(t0 - 2) * BR + cc), b = *(const v4u*)(Z + (size_t)(t0 - 1) * BR + cc);
            za[0] = bf_lo(a.x); za[1] = bf_hi(a.x); za[2] = bf_lo(a.y); za[3] = bf_hi(a.y); za[4] = bf_lo(a.z); za[5] = bf_hi(a.z); za[6] = bf_lo(a.w); za[7] = bf_hi(a.w);
            zb[0] = bf_lo(b.x); zb[1] = bf_hi(b.x); zb[2] = bf_lo(b.y); zb[3] = bf_hi(b.y); zb[4] = bf_lo(b.z); zb[5] = bf_hi(b.z); zb[6] = bf_lo(b.w); zb[7] = bf_hi(b.w);
        } else {
#pragma unroll
            for (int j = 0; j < 8; ++j) { za[j] = 0.f; zb[j] = 0.f; } }
#pragma unroll 4
        for (int t = t0; t < t0 + 32; ++t) {
            const v4u c = *(const v4u*)(Z + (size_t)t * BR + cc); const v4u g = *(const v4u*)(SGY + (size_t)t * GWID + cc);
            float zc[8], gg[8];
            zc[0] = bf_lo(c.x); zc[1] = bf_hi(c.x); zc[2] = bf_lo(c.y); zc[3] = bf_hi(c.y); zc[4] = bf_lo(c.z); zc[5] = bf_hi(c.z); zc[6] = bf_lo(c.w); zc[7] = bf_hi(c.w);
            gg[0] = bf_lo(g.x); gg[1] = bf_hi(g.x); gg[2] = bf_lo(g.y); gg[3] = bf_hi(g.y); gg[4] = bf_lo(g.z); gg[5] = bf_hi(g.z); gg[6] = bf_lo(g.w); gg[7] = bf_hi(g.w);
            float o[8];
#pragma unroll
            for (int j = 0; j < 8; ++j) { o[j] = gg[j] * (w0[j] * za[j] + w1[j] * zb[j] + w2[j] * zc[j]); za[j] = zb[j]; zb[j] = zc[j]; }
            v4u w; w.x = pkbf(o[0], o[1]); w.y = pkbf(o[2], o[3]); w.z = pkbf(o[4], o[5]); w.w = pkbf(o[6], o[7]);
            *(v4u*)(SGY + (size_t)t * GWID + cc) = w;
        }
    }
}

template <int MODE, bool OUTMUL>
__device__ __forceinline__ void attn256_task(const bf16* Qp, int qpitch, const bf16* Kp, int kpitch, int krow0, const bf16* Vtp, int vpitch, bf16* Op, int opitch,
                                             const int* pos, int prow0, float sl2, float sink2, int lane) {
    const int r32 = lane & 31, hi = lane >> 5;
    bf16x8 qf[4];
#pragma unroll
    for (int d0 = 0; d0 < 4; ++d0) qf[d0] = *(const bf16x8*)(Qp + (size_t)r32 * qpitch + d0 * 16 + hi * 8);
    float mrun = (MODE == 1) ? sink2 : NEGBIG, den = 0.f; int pq = 0; if (MODE == 1) pq = pos[prow0 + r32];
    f32x16 o[2]; o[0] = (f32x16){}; o[1] = (f32x16){};
#pragma unroll
    for (int hb = 0; hb < 2; ++hb) {
        f32x16 s[4];
#pragma unroll
        for (int kq = 0; kq < 4; ++kq) { const int kb = 4 * hb + kq;
            int kr = krow0 + 32 * kb + r32; if (MODE == 1 && kr < 0) kr = 0;
            const bf16* kp = Kp + (size_t)kr * kpitch + hi * 8;
            f32x16 accv = {};
#pragma unroll
            for (int d0 = 0; d0 < 4; ++d0) { const bf16x8 kf = *(const bf16x8*)(kp + d0 * 16); accv = __builtin_amdgcn_mfma_f32_32x32x16_bf16(kf, qf[d0], accv, 0, 0, 0); }
            s[kq] = accv; __builtin_amdgcn_sched_barrier(0);
        }
        float mx = NEGBIG;
        if (MODE == 1) {
#pragma unroll
            for (int kq = 0; kq < 4; ++kq)
#pragma unroll
                for (int g = 0; g < 4; ++g) { const int sidx = 32 * (4 * hb + kq) + 8 * g + 4 * hi; int kr = krow0 + sidx; const bool kvalid = kr >= 0; if (kr < 0) kr = 0;
                    const i32x4 pk = *(const i32x4*)(pos + kr);
#pragma unroll
                    for (int j = 0; j < 4; ++j) { const int rel = pq - pk[j]; const bool ok = kvalid && rel >= 0 && rel < 128;
                        const float v = ok ? (s[kq][4 * g + j] - sl2 * (float)rel) : NEGBIG; s[kq][4 * g + j] = v; mx = fmaxf(mx, v); } }
        } else {
#pragma unroll
            for (int kq = 0; kq < 4; ++kq)
#pragma unroll
                for (int r = 0; r < 16; ++r) mx = fmaxf(mx, s[kq][r]);
        }
        mx = fmaxf(mx, __shfl_xor(mx, 32));
        const float mnew = fmaxf(mrun, mx), al = __builtin_amdgcn_exp2f(mrun - mnew); mrun = mnew; den *= al; o[0] *= al; o[1] *= al;
#pragma unroll
        for (int kq = 0; kq < 4; ++kq)
#pragma unroll
            for (int r = 0; r < 16; ++r) { const float p = __builtin_amdgcn_exp2f(s[kq][r] - mnew); s[kq][r] = p; den += p; }
        __builtin_amdgcn_sched_barrier(0);
#pragma unroll
        for (int kq = 0; kq < 4; ++kq)
#pragma unroll
            for (int sh = 0; sh < 2; ++sh) { const int kb = 4 * hb + kq;
                v4u pw; pw.x = pkbf(s[kq][8 * sh + 0], s[kq][8 * sh + 1]); pw.y = pkbf(s[kq][8 * sh + 2], s[kq][8 * sh + 3]); pw.z = pkbf(s[kq][8 * sh + 4], s[kq][8 * sh + 5]); pw.w = pkbf(s[kq][8 * sh + 6], s[kq][8 * sh + 7]);
                const bf16x8 pb = __builtin_bit_cast(bf16x8, pw);
                int vc = krow0 + 32 * kb + 16 * sh + 8 * hi; if (MODE == 1 && vc < 0) vc = 0;
#pragma unroll
                for (int eb = 0; eb < 2; ++eb) { const bf16x8 av = *(const bf16x8*)(Vtp + (size_t)(32 * eb + r32) * vpitch + vc);
                    o[eb] = __builtin_amdgcn_mfma_f32_32x32x16_bf16(av, pb, o[eb], 0, 0, 0); }
                __builtin_amdgcn_sched_barrier(0);
            }
    }
    den += __shfl_xor(den, 32);
    if (MODE == 1) den += __builtin_amdgcn_exp2f(sink2 - mrun);
    const float inv = 1.0f / den;
#pragma unroll
    for (int eb = 0; eb < 2; ++eb)
#pragma unroll
        for (int g = 0; g < 4; ++g) { bf16* op = Op + (size_t)r32 * opitch + 32 * eb + 8 * g + 4 * hi;
            float v0 = o[eb][4 * g] * inv, v1 = o[eb][4 * g + 1] * inv, v2 = o[eb][4 * g + 2] * inv, v3 = o[eb][4 * g + 3] * inv;
            if (OUTMUL) { const u32x2 f = *(const u32x2*)op; v0 *= bf_lo(f.x); v1 *= bf_hi(f.x); v2 *= bf_lo(f.y); v3 *= bf_hi(f.y); }
            u32x2 w; w.x = pkbf(v0, v1); w.y = pkbf(v2, v3); *(u32x2*)op = w; }
}

template <bool OUTMUL> __device__ __forceinline__ void memattn_phase(Frame& F) {
    bf16* QM = (bf16*)(F.ws + WS_QM); const bf16* KM = (const bf16*)(F.ws + WS_KMEM); const bf16* VT = (const bf16*)(F.ws + WS_VMEMT); bf16* SGY = (bf16*)(F.ws + WS_SGY);
    for (int task = F.gw; task < 512 * 4; task += F.NGW) { const int hm = task & 3, rb = task >> 2, row0 = rb * 32;
        bf16* op = OUTMUL ? SGY + (size_t)row0 * GWID + BR + hm * 64 : QM + (size_t)row0 * QMW + hm * 64;
        attn256_task<0, OUTMUL>(QM + (size_t)row0 * QMW + hm * 64, QMW, KM + hm * 64, 256, 0, VT + (size_t)(hm * 64) * 256, 256, op, OUTMUL ? GWID : QMW, nullptr, 0, 0.f, 0.f, F.lane); }
}
__device__ __forceinline__ void swa_phase(Frame& F, const int* pos, const float* sinks) {
    const bf16* RQ = (const bf16*)(F.ws + WS_RQ); const bf16* KS = (const bf16*)(F.ws + WS_KS); const bf16* VTS = (const bf16*)(F.ws + WS_VTS); bf16* SGY = (bf16*)(F.ws + WS_SGY);
    for (int task = F.gw; task < 512 * 32; task += F.NGW) {
        const int qh = task & 31, rb = task >> 5, row0 = rb * 32, blk = rb >> 2, kvh = qh >> 3;
        const float slope = __builtin_amdgcn_exp2f(-8.0f * (float)(qh + 1) / 32.0f);
        attn256_task<1, true>(RQ + (size_t)row0 * BR + qh * 64, BR, KS + kvh * 64, 256, (blk - 1) * 128, VTS + (size_t)(kvh * 64) * M, M, SGY + (size_t)row0 * GWID + qh * 64, GWID,
                              pos, row0, slope * LOG2E, sinks[qh] * LOG2E, F.lane);
    }
}

constexpr int DA_KP = 272, DA_KB = 16384, DA_VB = 16384, DA_BUF = DA_KB + DA_VB + 256, DA_QOFF = 2 * DA_BUF;
__device__ __forceinline__ void diffattn_phase(Frame& F, const Args& a) {
    bf16* RQ = (bf16*)(F.ws + WS_RQ); const bf16* RK = (const bf16*)(F.ws + WS_RK); const bf16* RVT = (const bf16*)(F.ws + WS_RV);
    const int* pos = (const int*)a.in[2]; const float* subln = (const float*)a.in[19];
    const int tid = F.tid, lane = F.lane, w = F.wave, r32 = lane & 31, hi = lane >> 5;
    float lam;
    { const float p1 = ((const float*)a.in[15])[lane] * ((const float*)a.in[16])[lane], p2 = ((const float*)a.in[17])[lane] * ((const float*)a.in[18])[lane];
      lam = expf(wave_sum(p1)) - expf(wave_sum(p2)) + LAM_INIT; }
    for (int i = 0; i < 4; ++i) {
        const int L = i * F.G + F.bx; if (L >= 1024) break;
        const int v = L & 255, h = v >> 4, sidx = v & 15; const int qb = (i == 0) ? sidx : (i == 1) ? 31 - sidx : (i == 2) ? 32 + sidx : 63 - sidx;
        const float sl2 = __builtin_amdgcn_exp2f(-8.0f * (float)(h + 1) / 16.0f) * LOG2E;
        const int q0 = qb * 256 + w * 32;
        LAS unsigned char* Ql = F.lds + DA_QOFF + w * (32 * DA_KP);
#pragma unroll
        for (int ii = 0; ii < 8; ++ii) { const int id = lane + 64 * ii, qr_ = id >> 4, qc_ = id & 15;
            *(LAS v4u*)(Ql + qr_ * DA_KP + qc_ * 16) = *(const v4u*)(RQ + (size_t)(q0 + qr_) * BR + h * 128 + qc_ * 8); }
        const LAS unsigned char* Qrd = Ql + r32 * DA_KP + hi * 16;
        const float kq = sl2 * (float)pos[q0 + r32];
        float mrun[2] = {0.f, 0.f}, lrun[2] = {0.f, 0.f};
        f32x16 o[2][4];
#pragma unroll
        for (int c = 0; c < 2; ++c)
#pragma unroll
            for (int eb = 0; eb < 4; ++eb) o[c][eb] = (f32x16){};
        const int T_hi = 4 * qb + 3, t_mine = 4 * qb + (w >> 1);
        unsigned ksrc[2], vsrc[2];
#pragma unroll
        for (int p = 0; p < 2; ++p) { const int I = 2 * w + p; const int kr_ = 4 * I + (lane >> 4), kc_ = (lane & 15) ^ (kr_ & 15);
            ksrc[p] = (unsigned)(kr_ * BR + h * 128 + kc_ * 8);
            const int ve_ = 8 * I + (lane >> 3), vc_ = (lane & 7) ^ ((ve_ >> 1) & 7);
            vsrc[p] = (unsigned)((h * 128 + ve_) * M + vc_ * 8); }
#define DA_ISSUE(t, b) do { LAS unsigned char* B_ = F.lds + (b) * DA_BUF; \
        __builtin_amdgcn_global_load_lds((const unsigned*)(RK + (size_t)(ksrc[0] + (unsigned)(t) * 64u * BR)), (LAS unsigned*)(B_ + (2 * w) * 1024), 16, 0, 0); \
        __builtin_amdgcn_global_load_lds((const unsigned*)(RK + (size_t)(ksrc[1] + (unsigned)(t) * 64u * BR)), (LAS unsigned*)(B_ + (2 * w + 1) * 1024), 16, 0, 0); \
        __builtin_amdgcn_global_load_lds((const unsigned*)(RVT + (size_t)(vsrc[0] + (unsigned)(t) * 64u)), (LAS unsigned*)(B_ + DA_KB + (2 * w) * 1024), 16, 0, 0); \
        __builtin_amdgcn_global_load_lds((const unsigned*)(RVT + (size_t)(vsrc[1] + (unsigned)(t) * 64u)), (LAS unsigned*)(B_ + DA_KB + (2 * w + 1) * 1024), 16, 0, 0); \
        if (tid < 64) *(LAS float*)(B_ + DA_KB + DA_VB + tid * 4) = sl2 * (float)pos[(t) * 64 + tid]; } while (0)
        DA_ISSUE(T_hi, 0); asm volatile("s_waitcnt vmcnt(0) lgkmcnt(0)" ::: "memory"); __syncthreads();
        int b = 0;
        const int ksw = (r32 & 15), vsw = (r32 >> 1) & 7;
        for (int t = T_hi; t >= 0; --t, b ^= 1) {
            if (t > 0) DA_ISSUE(t - 1, b ^ 1);
            if (t <= t_mine) {
                const LAS unsigned char* Kl = F.lds + b * DA_BUF; const LAS unsigned char* Vl = Kl + DA_KB; const LAS float* kbf = (const LAS float*)(Kl + DA_KB + DA_VB);
                const bool need_mask = (t * 64 + 63 > q0);
#pragma unroll
                for (int c = 0; c < 2; ++c) {
#pragma unroll
                  for (int kvb = 0; kvb < 2; ++kvb) {
                    if (t * 64 + 32 * kvb > q0 + 31) continue;
                    const bool fst = (t == t_mine) && (kvb == 0);
                    f32x16 s0; const float cm = -kq - mrun[c];
#pragma unroll
                    for (int g = 0; g < 4; ++g) { const f32x4 k0 = *(const LAS f32x4*)(kbf + 32 * kvb + 8 * g + 4 * hi);
#pragma unroll
                        for (int j = 0; j < 4; ++j) { float v_ = k0[j] + cm; if (need_mask && k0[j] > kq) v_ = NEGBIG; s0[4 * g + j] = v_; } }
                    __builtin_amdgcn_sched_barrier(0);
#pragma unroll
                    for (int d0 = 0; d0 < 4; ++d0) { const int ch = ((8 * c + 2 * d0 + hi) ^ ksw) * 16;
                        const bf16x8 ka = *(const LAS bf16x8*)(Kl + (32 * kvb + r32) * 256 + ch);
                        const bf16x8 qv = *(const LAS bf16x8*)(Qrd + (c * 64 + d0 * 16) * 2);
                        s0 = __builtin_amdgcn_mfma_f32_32x32x16_bf16(ka, qv, s0, 0, 0, 0); }
                    __builtin_amdgcn_sched_barrier(0);
                    float mx = s0[0];
#pragma unroll
                    for (int r = 1; r < 16; ++r) mx = fmaxf(mx, s0[r]);
                    mx = fmaxf(mx, __shfl_xor(mx, 32));
                    if (fst || __any(mx > 8.0f)) {
                        const float dl = fst ? mx : fmaxf(mx, 0.f); mrun[c] += dl; const float al = __builtin_amdgcn_exp2f(-dl); lrun[c] *= al;
#pragma unroll
                        for (int r = 0; r < 16; ++r) s0[r] -= dl;
#pragma unroll
                        for (int eb = 0; eb < 4; ++eb) o[c][eb] *= al;
                    }
                    float ls = 0.f;
#pragma unroll
                    for (int r = 0; r < 16; ++r) { s0[r] = __builtin_amdgcn_exp2f(s0[r]); ls += s0[r]; }
                    lrun[c] += ls;
                    __builtin_amdgcn_sched_barrier(0);
#pragma unroll
                    for (int sh = 0; sh < 2; ++sh) { const int ks = 2 * kvb + sh;
                        v4u pw; pw.x = pkbf(s0[8 * sh + 0], s0[8 * sh + 1]); pw.y = pkbf(s0[8 * sh + 2], s0[8 * sh + 3]); pw.z = pkbf(s0[8 * sh + 4], s0[8 * sh + 5]); pw.w = pkbf(s0[8 * sh + 6], s0[8 * sh + 7]);
                        const bf16x8 pb = __builtin_bit_cast(bf16x8, pw); const int vch = ((2 * ks + hi) ^ vsw) * 16;
#pragma unroll
                        for (int eb = 0; eb < 4; ++eb) { const bf16x8 av = *(const LAS bf16x8*)(Vl + (32 * eb + r32) * 128 + vch);
                            o[c][eb] = __builtin_amdgcn_mfma_f32_32x32x16_bf16(av, pb, o[c][eb], 0, 0, 0); }
                        __builtin_amdgcn_sched_barrier(0);
                    }
                  }
                }
            }
            asm volatile("s_waitcnt vmcnt(0) lgkmcnt(0)" ::: "memory"); __syncthreads();
        }
#undef DA_ISSUE
        const float l0 = lrun[0] + __shfl_xor(lrun[0], 32), l1 = lrun[1] + __shfl_xor(lrun[1], 32);
        const float i0 = 1.0f / l0, i1 = lam / l1; float sq = 0.f;
#pragma unroll
        for (int eb = 0; eb < 4; ++eb)
#pragma unroll
            for (int r = 0; r < 16; ++r) { const float v2 = o[0][eb][r] * i0 - o[1][eb][r] * i1; o[0][eb][r] = v2; sq += v2 * v2; }
        sq += __shfl_xor(sq, 32);
        const float rn = (1.0f / sqrtf(sq * (1.0f / 128.0f) + EPS)) * (1.0f - LAM_INIT);
#pragma unroll
        for (int eb = 0; eb < 4; ++eb)
#pragma unroll
            for (int g = 0; g < 4; ++g) { const int e = 32 * eb + 8 * g + 4 * hi; const f32x4 sg = *(const f32x4*)(subln + e);
                u32x2 wv; wv.x = pkbf(o[0][eb][4 * g] * rn * sg[0], o[0][eb][4 * g + 1] * rn * sg[1]); wv.y = pkbf(o[0][eb][4 * g + 2] * rn * sg[2], o[0][eb][4 * g + 3] * rn * sg[3]);
                *(u32x2*)(RQ + (size_t)(q0 + r32) * BR + h * 128 + e) = wv; }
    }
}

struct Sched2 { pg8::StaticOrder so; int one, mine;
    __device__ __forceinline__ bool next(int i, pg8::Unit& u) const { if (one) { if (i > 0 || !mine) return false; u.pm = 0; u.pn = 0; return true; } return so.next(i, u); }
    __device__ __forceinline__ void a_ready(const pg8::Unit&) const {}
    __device__ __forceinline__ void done(const pg8::Unit&) const {} };

__global__ void __launch_bounds__(NWAVES * 64, 2) mega_fwd(Args args) {
    extern __shared__ __attribute__((aligned(16))) unsigned char lds_raw[];
    Frame F; F.lds = (LAS unsigned char*)lds_raw; F.tid = threadIdx.x; F.lane = F.tid & 63; F.wave = __builtin_amdgcn_readfirstlane(F.tid >> 6);
    F.G = gridDim.x; F.bx = blockIdx.x; F.gw = F.bx * NWAVES + F.wave; F.NGW = F.G * NWAVES; F.ws = args.ws;
    volatile LAS unsigned* MISC = (volatile LAS unsigned*)(F.lds + MISC_OFF);
    if (F.tid < 32) ((LAS unsigned*)(F.lds + MISC_OFF))[F.tid] = 0u;
    __syncthreads();
    const bool single = (args.ph_hi - args.ph_lo) > 1;
    XcdBarrier bar; bar.bar = (unsigned*)(F.ws + WS_BAR); bar.x = 0; bar.st = nullptr;
    if (single) bar = xcd_barrier_post((unsigned*)(F.ws + WS_BAR), MISC + 8);
    const float* rstd = (const float*)(F.ws + WS_RSTD); float* ss = (float*)(F.ws + WS_QM);
    const bf16* XB = (const bf16*)(F.ws + WS_XB); const bf16* WIN = (const bf16*)(F.ws + WS_WIN); const bf16* WOUT = (const bf16*)(F.ws + WS_WOUT); const bf16* WMEM = (const bf16*)(F.ws + WS_WMEM);
    const bf16* MEMN = (const bf16*)(F.ws + WS_MEMN);
    int ph = 0;
    for (int L = 0; L <= 4; ++L) {
        const int kind = (L == 3) ? 0 : L;
        const int nsub = (L == 4) ? 1 : (kind == 1) ? 5 : 4;
        for (int sub = 0; sub < nsub; ++sub, ++ph) {
            if (ph < args.ph_lo || ph >= args.ph_hi) continue;
            frame_refresh(F);
            int op = sub; if (kind != 1 && sub == 3) op = 4;
            if (op == 0) prep_phase(F, args, L);
            else if (op == 2) {
                if (kind == 0) { conv_phase(F, (const float*)args.in[(L == 0) ? 8 : 33]); memattn_phase<true>(F); }
                else if (kind == 1) { diffattn_phase(F, args); memattn_phase<false>(F); }
                else { swa_phase(F, (const int*)args.in[2], (const float*)args.in[26]); memattn_phase<true>(F); }
            } else {
                for (int j = 0; j < 4; ++j) {
                    Epi E{}; E.rstd = rstd; E.ws = F.ws; E.ss = ss; E.ldc = 256;
                    const bf16* A = XB; const bf16* Bt = WIN; int Mg = M, Ng = 0, Kg = D, one = 0, mine = 0; bool valid = true;
                    if (op == 1) {
                        const int nmain = (kind == 0) ? 1 : 2;
                        if (j == 0) { E.mode = (kind == 0) ? EM_CONV : (kind == 1) ? EM_DIFF1 : EM_SWA; Ng = (kind == 0) ? 8704 : (kind == 1) ? 4352 : 4864; }
                        else if (j < nmain) { E.mode = EM_VT; E.ldc = M; Bt = XB; Ng = M;
                            if (kind == 1) { A = WIN + (size_t)4352 * D; Mg = 2048; E.o0 = (bf16*)(F.ws + WS_RV); } else { A = WIN + (size_t)4864 * D; Mg = 256; E.o0 = (bf16*)(F.ws + WS_VTS); } }
                        else if (j == nmain) { E.mode = EM_PLAIN; A = MEMN; Bt = WMEM; Mg = 256; Ng = 256; one = 1; mine = (F.bx == F.G - 1); E.o0 = (bf16*)(F.ws + WS_KMEM); }
                        else if (j == nmain + 1) { E.mode = EM_VT; E.rstd = nullptr; A = WMEM + (size_t)256 * D; Bt = MEMN; Mg = 256; Ng = 256; one = 1; mine = (F.bx == F.G - 2); E.o0 = (bf16*)(F.ws + WS_VMEMT); }
                        else valid = false;
                    } else if (op == 3) { if (j == 0) { E.mode = EM_GATE; Bt = WIN + (size_t)6400 * D; Ng = GWID; } else valid = false; }
                    else { if (j == 0) { E.mode = EM_OUT; A = (const bf16*)(F.ws + WS_SGY); Bt = WOUT; Ng = D; Kg = GWID; } else valid = false; }
                    if (!valid) break;
                    pg8::Gemm g{A, Bt, Mg, Ng, Kg}; Sched2 S; S.so.init(Mg, Ng, F.G, F.bx); S.one = one; S.mine = mine;
                    pg8::gemm_phase<Epi, Sched2, true, true>(F.lds, g, S, E);
                }
            }
            if (single && ph + 1 < args.ph_hi) { if (ph == args.ph_lo) { __threadfence(); cg::this_grid().sync(); } else xcd_barrier(bar); }
        }
    }
}

constexpr int N_PHASES = 18;
#ifndef MK_PER_PHASE
#define MK_PER_PHASE 1
#endif
extern "C" void kernel_launch(void* const* d_in, const int* in_sizes, int n_in, void* d_out, int out_size, void* d_ws, size_t ws_size, hipStream_t stream) {
    static int ready = 0;
    if (!ready) {
        if (n_in != 35 || out_size != M * D || ws_size < WS_END) { fprintf(stderr, "kernel_launch: unexpected shapes (n_in %d out %d ws %zu)\n", n_in, out_size, ws_size); ready = -1; return; }
        if (hipFuncSetAttribute((const void*)mega_fwd, hipFuncAttributeMaxDynamicSharedMemorySize, LDS_BYTES) != hipSuccess) { fprintf(stderr, "hipFuncSetAttribute failed\n"); ready = -1; return; }
        ready = 1;
    }
    if (ready < 0) return;
    (void)hipMemsetAsync((char*)d_ws + WS_BAR, 0, 64 * KiB, stream);
    Args a{};
    for (int i = 0; i < 35; ++i) a.in[i] = d_in[i];
    a.out = (float*)d_out; a.ws = (unsigned char*)d_ws;
    const int grid = 256;
#if MK_PER_PHASE
    for (int p = 0; p < N_PHASES; ++p) { a.ph_lo = p; a.ph_hi = p + 1; hipLaunchKernelGGL(mega_fwd, dim3(grid), dim3(NWAVES * 64), LDS_BYTES, stream, a); }
#else
    a.ph_lo = 0; a.ph_hi = N_PHASES;
    void* kargs[] = {&a};
    hipError_t e = hipLaunchCooperativeKernel((const void*)mega_fwd, dim3(grid), dim3(NWAVES * 64), kargs, LDS_BYTES, stream);
    if (e != hipSuccess) fprintf(stderr, "cooperative launch failed: %s\n", hipGetErrorString(e));
#endif
}
```

```cpp
#include <hip/hip_runtime.h>
#include <hip/hip_cooperative_groups.h>
#include <cstdio>
#include <cstdint>
namespace cg = cooperative_groups;
namespace pg8 {
#define PG8_LAS __attribute__((address_space(3)))
typedef unsigned short bf16_t;
typedef short bf16x8 __attribute__((ext_vector_type(8)));
typedef float f32x4 __attribute__((ext_vector_type(4)));
typedef unsigned u32x4 __attribute__((ext_vector_type(4)));
constexpr int BM = 256, BK = 64, HALF = 128, HTB = HALF * BK * 2  , STAGE_BYTES = 8 * HTB, NXCD = 8, WGM = 8;

__host__ __device__ __forceinline__ int lds_byte(int r, int c) { const int st = (r >> 4) * 2 + (c >> 5), rr = r & 15, cc = c & 31, ob = rr * 64 + cc * 2; return st * 1024 + (ob ^ (((ob >> 9) & 1) << 5)); }
__host__ __device__ __forceinline__ void stage_rc(int b, int& R, int& C) { const int st = b / 1024, sb = b % 1024, swz = sb ^ (((sb >> 9) & 1) << 5); R = (st >> 1) * 16 + swz / 64; C = (st & 1) * 32 + (swz % 64) / 2; }
__host__ __device__ __forceinline__ int perm32(int rho) { const int n = rho >> 4, i = rho & 15; return 8 * (i >> 2) + 4 * n + (i & 3); }

struct Unit { int pm, pn; };
struct Gemm { const bf16_t* A; const bf16_t* Bt; int M, N, K; };

struct StaticOrder {
    int nM, nN, nwg, G, c;
    __host__ __device__ void init(int M, int N, int G_, int c_) { nM = M / BM; nN = N / BM; nwg = nM * nN; G = G_; c = c_; }
    __host__ __device__ bool next(int i, Unit& u) const {
        const long L = (long)i * G + c; if (L >= nwg) return false;
        int wgid = (int)L; { const int q = nwg / NXCD, r = nwg % NXCD, xcd = wgid % NXCD, off = wgid / NXCD; wgid = (xcd < r ? xcd * (q + 1) : r * (q + 1) + (xcd - r) * q) + off; }
        const int nig = WGM * nN, gid = wgid / nig, fm = gid * WGM, gsz = (nM - fm) < WGM ? (nM - fm) : WGM;
        u.pm = fm + ((wgid % nig) % gsz); u.pn = (wgid % nig) / gsz; return true;
    }
    __device__ __forceinline__ void a_ready(const Unit&) const {}
    __device__ __forceinline__ void done(const Unit&) const {}
};

__device__ __forceinline__ unsigned cvt_pk_bf16(float lo, float hi) { unsigned r; asm volatile("v_cvt_pk_bf16_f32 %0, %1, %2" : "=v"(r) : "v"(lo), "v"(hi)); return r; }
template <class Epi, class Sched, bool ALIGN_EPI = false, bool SP2 = false>
__device__ __forceinline__ void gemm_phase(PG8_LAS unsigned char* lds, const Gemm g, const Sched& S, const Epi& E) {
    int tid_ = threadIdx.x; asm volatile("" : "+v"(tid_)); const int tid = tid_, wid = __builtin_amdgcn_readfirstlane(tid >> 6), lane = tid & 63, wr = wid >> 2, wc = wid & 3, fr = lane & 15, fq = lane >> 4;
    const int K = g.K, nt = K / BK;
    unsigned voffA[2], voffB[2];
#pragma unroll
    for (int i = 0; i < 2; ++i) { int R, C; stage_rc(tid * 16 + i * 8192, R, C); const int Rb = Epi::PERM ? ((R & ~31) + perm32(R & 31)) : R;
        voffA[i] = (unsigned)(R * K + C) * 2u; voffB[i] = (unsigned)(Rb * K + C) * 2u; }
    const size_t kstep = (size_t)(BK * 2);
    const size_t hstep = (size_t)HALF * K * 2;
    const size_t tstep = 2 * hstep;
    const unsigned ldsw = (unsigned)wid * 1024u;
    const int aoff = lds_byte(wr * 64 + fr, fq * 8), boff = lds_byte(wc * 32 + fr, fq * 8);
#define PG8_SA(b, h) (((b) * 2 + (h)) * HTB)
#define PG8_SB(b, h) ((4 + (b) * 2 + (h)) * HTB)
#define PG8_STAGE(bufoff, gbase, voff) do { _Pragma("unroll") for (int _i = 0; _i < 2; ++_i) \
        __builtin_amdgcn_global_load_lds((const unsigned*)((const char*)(gbase) + (voff)[_i]), (PG8_LAS unsigned*)(lds + (bufoff) + ldsw + _i * 8192), 16, 0, 0); } while (0)
#define PG8_LDA(dst, b, h) do { _Pragma("unroll") for (int m = 0; m < 4; ++m) _Pragma("unroll") for (int k = 0; k < 2; ++k) dst[m][k] = *(const PG8_LAS bf16x8*)(lds + PG8_SA(b, h) + aoff + m * 2048 + k * 1024); } while (0)
#define PG8_LDB(dst, b, h) do { _Pragma("unroll") for (int n = 0; n < 2; ++n) _Pragma("unroll") for (int k = 0; k < 2; ++k) dst[n][k] = *(const PG8_LAS bf16x8*)(lds + PG8_SB(b, h) + boff + n * 2048 + k * 1024); } while (0)
#define PG8_MMA(ai, bj, At, Bt) do { __builtin_amdgcn_s_setprio(1); _Pragma("unroll") for (int m = 0; m < 4; ++m) _Pragma("unroll") for (int n = 0; n < 2; ++n) _Pragma("unroll") for (int k = 0; k < 2; ++k) \
        acc[ai][bj][m][n] = __builtin_amdgcn_mfma_f32_16x16x32_bf16(Bt[n][k], At[m][k], acc[ai][bj][m][n], 0, 0, 0); __builtin_amdgcn_s_setprio(0); } while (0)
#define PG8_WAIT_V(n) asm volatile("s_waitcnt vmcnt(" #n ")" ::: "memory")
#define PG8_WAIT_L(n) asm volatile("s_waitcnt lgkmcnt(" #n ")" ::: "memory")
#define PG8_BAR __builtin_amdgcn_s_barrier()
#define PG8_SCHED __builtin_amdgcn_sched_barrier(0)
    Unit cur, nxt; int ui = 0;
    if (!S.next(0, cur)) return;
    f32x4 acc[2][2][4][2];
#pragma unroll
    for (int a = 0; a < 2; ++a)
#pragma unroll
        for (int b = 0; b < 2; ++b)
#pragma unroll
            for (int m = 0; m < 4; ++m)
#pragma unroll
                for (int n = 0; n < 2; ++n) acc[a][b][m][n] = (f32x4){0.f, 0.f, 0.f, 0.f};
    bf16x8 At[4][2], B0[2][2], B1[2][2];
    const char* cA = (const char*)g.A + (size_t)cur.pm * tstep; const char* cB = (const char*)g.Bt + (size_t)cur.pn * tstep;
    S.a_ready(cur);
    if constexpr (SP2) {
        PG8_STAGE(PG8_SB(0, 0), cB, voffB); PG8_STAGE(PG8_SB(0, 1), cB + hstep, voffB); PG8_STAGE(PG8_SA(0, 0), cA, voffA); PG8_STAGE(PG8_SA(0, 1), cA + hstep, voffA);
        if (wr == 1) PG8_BAR;
        PG8_WAIT_V(2); PG8_BAR;
        PG8_STAGE(PG8_SB(1, 0), cB + kstep, voffB); PG8_STAGE(PG8_SA(1, 0), cA + kstep, voffA); PG8_STAGE(PG8_SB(1, 1), cB + hstep + kstep, voffB);
        PG8_WAIT_V(6); PG8_BAR;
    } else {
        PG8_STAGE(PG8_SB(0, 0), cB, voffB); PG8_STAGE(PG8_SA(0, 0), cA, voffA); PG8_STAGE(PG8_SB(0, 1), cB + hstep, voffB); PG8_STAGE(PG8_SA(0, 1), cA + hstep, voffA);
        if (wr == 1) PG8_BAR;
        PG8_WAIT_V(4); PG8_BAR;
        PG8_STAGE(PG8_SB(1, 0), cB + kstep, voffB); PG8_STAGE(PG8_SA(1, 0), cA + kstep, voffA); PG8_STAGE(PG8_SB(1, 1), cB + hstep + kstep, voffB);
        PG8_WAIT_V(6); PG8_BAR;
    }
    for (;;) {
        const bool has_next = S.next(ui + 1, nxt);
        const char* nA = has_next ? (const char*)g.A + (size_t)nxt.pm * tstep : cA; const char* nB = has_next ? (const char*)g.Bt + (size_t)nxt.pn * tstep : cB;
        for (int t = 0; t < nt; t += 2) {
            const bool last = (t == nt - 2);
            const char* a1 = cA + (size_t)(t + 1) * kstep;
            const char* a2 = last ? nA : cA + (size_t)(t + 2) * kstep; const char* b2 = last ? nB : cB + (size_t)(t + 2) * kstep;
            const char* a3 = a2 + kstep; const char* b3 = b2 + kstep;
            if (last && has_next) S.a_ready(nxt);
            if constexpr (SP2) {
            PG8_LDB(B0, 0, 0); PG8_LDB(B1, 0, 1); PG8_SCHED; PG8_LDA(At, 0, 0); PG8_STAGE(PG8_SA(1, 1), a1 + hstep, voffA);
            PG8_WAIT_V(8); PG8_WAIT_L(0); PG8_BAR; PG8_MMA(0, 0, At, B0); PG8_MMA(0, 1, At, B1); PG8_BAR; PG8_SCHED;
            PG8_LDA(At, 0, 1); PG8_STAGE(PG8_SB(0, 0), b2, voffB); PG8_STAGE(PG8_SB(0, 1), b2 + hstep, voffB); PG8_STAGE(PG8_SA(0, 0), a2, voffA);
            PG8_WAIT_V(8); PG8_WAIT_L(0); PG8_BAR; PG8_MMA(1, 0, At, B0); PG8_MMA(1, 1, At, B1); PG8_BAR; PG8_SCHED;
            PG8_LDB(B0, 1, 0); PG8_LDB(B1, 1, 1); PG8_SCHED; PG8_LDA(At, 1, 0); PG8_STAGE(PG8_SA(0, 1), a2 + hstep, voffA);
            PG8_WAIT_V(8); PG8_WAIT_L(0); PG8_BAR; PG8_MMA(0, 0, At, B0); PG8_MMA(0, 1, At, B1); PG8_BAR; PG8_SCHED;
            PG8_LDA(At, 1, 1); PG8_STAGE(PG8_SB(1, 0), b3, voffB); PG8_STAGE(PG8_SB(1, 1), b3 + hstep, voffB); PG8_STAGE(PG8_SA(1, 0), a3, voffA);
            PG8_WAIT_V(8); PG8_WAIT_L(0); PG8_BAR; PG8_MMA(1, 0, At, B0); PG8_MMA(1, 1, At, B1); PG8_BAR; PG8_SCHED;
            } else {
            PG8_LDB(B0, 0, 0); PG8_SCHED; PG8_LDA(At, 0, 0); PG8_STAGE(PG8_SA(1, 1), a1 + hstep, voffA);
            PG8_WAIT_L(8); PG8_BAR; PG8_WAIT_L(0); PG8_MMA(0, 0, At, B0); PG8_BAR; PG8_SCHED;
            PG8_LDB(B1, 0, 1); PG8_STAGE(PG8_SB(0, 0), b2, voffB);
            PG8_BAR; PG8_WAIT_L(0); PG8_MMA(0, 1, At, B1); PG8_BAR;
            PG8_LDA(At, 0, 1); PG8_STAGE(PG8_SA(0, 0), a2, voffA);
            PG8_BAR; PG8_WAIT_L(0); PG8_MMA(1, 0, At, B0); PG8_BAR; PG8_SCHED;
            PG8_STAGE(PG8_SB(0, 1), b2 + hstep, voffB);
            PG8_WAIT_V(6); PG8_BAR; PG8_MMA(1, 1, At, B1); PG8_BAR;
            PG8_LDB(B0, 1, 0); PG8_SCHED; PG8_LDA(At, 1, 0); PG8_STAGE(PG8_SA(0, 1), a2 + hstep, voffA);
            PG8_WAIT_L(8); PG8_BAR; PG8_WAIT_L(0); PG8_MMA(0, 0, At, B0); PG8_BAR; PG8_SCHED;
            PG8_LDB(B1, 1, 1); PG8_STAGE(PG8_SB(1, 0), b3, voffB);
            PG8_BAR; PG8_WAIT_L(0); PG8_MMA(0, 1, At, B1); PG8_BAR;
            PG8_LDA(At, 1, 1); PG8_STAGE(PG8_SA(1, 0), a3, voffA);
            PG8_BAR; PG8_WAIT_L(0); PG8_MMA(1, 0, At, B0); PG8_BAR; PG8_SCHED;
            PG8_STAGE(PG8_SB(1, 1), b3 + hstep, voffB);
            PG8_WAIT_V(6); PG8_BAR; PG8_MMA(1, 1, At, B1); PG8_BAR;
            }
        }
        if constexpr (ALIGN_EPI) { if (wr == 0) PG8_BAR; }
        if constexpr (!Epi::AFTER_DRAIN) { E(acc, cur, wr, wc, fr, fq); S.done(cur); }
        if (!has_next) break;
#pragma unroll
        for (int a = 0; a < 2; ++a)
#pragma unroll
            for (int b = 0; b < 2; ++b)
#pragma unroll
                for (int m = 0; m < 4; ++m)
#pragma unroll
                    for (int n = 0; n < 2; ++n) acc[a][b][m][n] = (f32x4){0.f, 0.f, 0.f, 0.f};
        cur = nxt; cA = nA; cB = nB; ++ui;
        if constexpr (ALIGN_EPI) { if (wr == 1) PG8_BAR; }
    }
    PG8_WAIT_V(0);
    if constexpr (!ALIGN_EPI) { if (wr == 0) PG8_BAR; }
    PG8_BAR;
    if constexpr (Epi::AFTER_DRAIN) { E.fused(acc, cur, wr, wc, fr, fq, lds, wid, lane); S.done(cur); }
#undef PG8_SA
#undef PG8_SB
#undef PG8_STAGE
#undef PG8_LDA
#undef PG8_LDB
#undef PG8_MMA
#undef PG8_WAIT_V
#undef PG8_WAIT_L
#undef PG8_BAR
#undef PG8_SCHED
}
}
#define GAS __attribute__((address_space(1)))
#define LAS __attribute__((address_space(3)))
typedef unsigned short bf16;
typedef unsigned v4u __attribute__((ext_vector_type(4)));
typedef float f32x4 __attribute__((ext_vector_type(4)));
typedef short bf16x8 __attribute__((ext_vector_type(8)));
typedef GAS unsigned gu32;
typedef GAS unsigned long long gu64;
#define RLX_AGENT __ATOMIC_RELAXED, __HIP_MEMORY_SCOPE_AGENT
#define LDS_WAIT() asm volatile("s_waitcnt lgkmcnt(0)" ::: "memory")
#define VM_WAIT() asm volatile("s_waitcnt vmcnt(0)" ::: "memory")
__device__ __forceinline__ unsigned long long rt() { return __builtin_amdgcn_s_memrealtime(); }
__device__ __forceinline__ unsigned f2bf(float f) { unsigned u = __builtin_bit_cast(unsigned, f); return (u + 0x7fffu + ((u >> 16) & 1u)) >> 16; }
__device__ __forceinline__ unsigned pk2(float lo, float hi) { return f2bf(lo) | (f2bf(hi) << 16); }

#define XB_TMO      128
#define XB_XCNT(j)  (256  + 64 * (j))
#define XB_XSUB(j)  (1280 + 64 * (j))
#define XB_XGEN(j)  (2304 + 64 * (j))
#define XB_TOP      3328
#define XB_TOPGEN   3392
#define XCD_BAR_WORDS 3456
#define XB_SPIN_CAP (1u << 18)

__device__ __forceinline__ unsigned xb_ld(unsigned* p)              { return __hip_atomic_load(p, __ATOMIC_RELAXED, __HIP_MEMORY_SCOPE_AGENT); }
__device__ __forceinline__ unsigned xb_add(unsigned* p, unsigned v) { return __hip_atomic_fetch_add(p, v, __ATOMIC_RELAXED, __HIP_MEMORY_SCOPE_AGENT); }
__device__ __forceinline__ unsigned xb_xcc_id() { return (unsigned)__builtin_amdgcn_s_getreg((3 << 11) | 20) & 0xFu; }
#define XB_SPIN(cond, bar) do { unsigned _sp = 0; while (cond) { __builtin_amdgcn_s_sleep(1); \
    if ((++_sp & 255u) == 0u) { if (xb_ld(&(bar)[XB_TMO])) break; if (_sp > XB_SPIN_CAP) { atomicAdd(&(bar)[XB_TMO], 1u); break; } } } } while (0)

struct XcdBarrier {
    unsigned* bar; unsigned x;
    volatile LAS unsigned* st;
};

__device__ __forceinline__ XcdBarrier xcd_barrier_post(unsigned* bar, volatile LAS unsigned* st) {
    XcdBarrier b; b.bar = bar; b.x = xb_xcc_id(); b.st = st;
    if (threadIdx.x == 0) (void)xb_add(&bar[XB_XCNT(b.x)], 1u);
    return b;
}
__device__ __forceinline__ void xcd_barrier_complete(unsigned* bar, unsigned x, unsigned& nloc, unsigned& nx) {
    const unsigned G = gridDim.x * gridDim.y * gridDim.z;
    unsigned sum, cnt, mine, sp = 0u;
    for (;;) {
        sum = 0u; cnt = 0u; mine = 0u;
#pragma unroll
        for (unsigned j = 0; j < 16; ++j) { const unsigned c = xb_ld(&bar[XB_XCNT(j)]); sum += c; cnt += (c > 0u) ? 1u : 0u; mine = (j == x) ? c : mine; }
        if (sum == G) break;
        __builtin_amdgcn_s_sleep(1);
        if ((++sp & 255u) == 0u) { if (xb_ld(&bar[XB_TMO])) break; if (sp > XB_SPIN_CAP) { atomicAdd(&bar[XB_TMO], 1u); break; } }
    }
    nloc = mine > 0u ? mine : 1u; nx = cnt > 0u ? cnt : 1u;
}

__device__ __forceinline__ void xcd_barrier(const XcdBarrier& b) {
    asm volatile("s_waitcnt vmcnt(0)" ::: "memory");
    __syncthreads();
    if (threadIdx.x == 0) {
        unsigned* bar = b.bar;
        __builtin_amdgcn_s_waitcnt(0);
        unsigned nloc = b.st[0], nx = b.st[1];
        if (nloc == 0u) { xcd_barrier_complete(bar, b.x, nloc, nx); b.st[0] = nloc; b.st[1] = nx; }
        const unsigned old = xb_add(&bar[XB_XSUB(b.x)], 1u);
        const unsigned gen = old / nloc;
        if (old + 1u == (gen + 1u) * nloc) {
            __builtin_amdgcn_fence(__ATOMIC_RELEASE, "agent");
            asm volatile("s_waitcnt vmcnt(0)" ::: "memory");
            const unsigned og = xb_add(&bar[XB_TOP], 1u);
            const unsigned tg = og / nx;
            if (og + 1u == (tg + 1u) * nx) xb_add(&bar[XB_TOPGEN], 1u);
            else XB_SPIN(xb_ld(&bar[XB_TOPGEN]) == tg, bar);
            __builtin_amdgcn_fence(__ATOMIC_ACQUIRE, "agent");
            xb_add(&bar[XB_XGEN(b.x)], 1u);
            asm volatile("s_waitcnt vmcnt(0)" ::: "memory");
        } else {
            XB_SPIN(xb_ld(&bar[XB_XGEN(b.x)]) == gen, bar);
            __builtin_amdgcn_fence(__ATOMIC_ACQUIRE, "agent");
            asm volatile("s_waitcnt vmcnt(0)" ::: "memory");
        }
    }
    __syncthreads();
}

constexpr int M = 16384, D = 1024, BR = 2048, GWID = 2304, QMW = 256;
constexpr float EPS = 1e-6f, LOG2E = 1.4426950408889634f, C2 = 0.125f * 1.4426950408889634f, NEGBIG = -1e30f;
constexpr float LAM_INIT = 0.35550907f;
typedef float f32x16 __attribute__((ext_vector_type(16)));
typedef unsigned u32x2 __attribute__((ext_vector_type(2)));
typedef int i32x4 __attribute__((ext_vector_type(4)));
typedef short s16x4 __attribute__((ext_vector_type(4)));

constexpr size_t MiB = 1u << 20, KiB = 1024;
constexpr size_t WS_BAR = 0;
constexpr size_t WS_RSTD = 64 * KiB, WS_SS = 128 * KiB, WS_KMEM = 192 * KiB, WS_VMEMT = 320 * KiB, WS_MEMN = 448 * KiB, WS_MISC = 960 * KiB;
constexpr size_t WS_WMEM = 1 * MiB, WS_WIN = 2 * MiB, WS_WOUT = 19 * MiB, WS_XB = 24 * MiB, WS_QM = 56 * MiB;
constexpr size_t WS_RQ = 64 * MiB, WS_RK = 128 * MiB, WS_RV = 192 * MiB, WS_END = 256 * MiB;
constexpr size_t WS_SGY = 128 * MiB;
constexpr size_t WS_KS = 200 * MiB, WS_VTS = 208 * MiB;
constexpr int LDS_BYTES = 147456, MISC_OFF = LDS_BYTES - 128;
constexpr int NWAVES = 8;

__device__ __forceinline__ float silu_f(float x) { return x * __builtin_amdgcn_rcpf(1.0f + __builtin_amdgcn_exp2f(-x * LOG2E)); }
__device__ __forceinline__ unsigned pkbf(float lo, float hi) { return pg8::cvt_pk_bf16(lo, hi); }
__device__ __forceinline__ float bf_lo(unsigned u) { return __uint_as_float(u << 16); }
__device__ __forceinline__ float bf_hi(unsigned u) { return __uint_as_float(u & 0xffff0000u); }

enum { EM_CONV = 0, EM_DIFF1, EM_VT, EM_GATE, EM_SWA, EM_PLAIN, EM_OUT };
struct Epi {
    static constexpr bool PERM = true, AFTER_DRAIN = false;
    int mode; int ldc; const float* rstd; unsigned char* ws; bf16* o0; float* ss;
    __device__ __forceinline__ void operator()(const pg8::f32x4 (&acc)[2][2][4][2], const pg8::Unit& u, int wr, int wc, int fr, int fq) const {
        using pg8::f32x4; typedef unsigned u32x4v __attribute__((ext_vector_type(4)));
        const int row0 = u.pm * 256 + wr * 64 + fr, tc8 = wc * 32 + fq * 8;
        bf16* RQ = (bf16*)(ws + WS_RQ); bf16* RK = (bf16*)(ws + WS_RK); bf16* QM = (bf16*)(ws + WS_QM); bf16* SGY = (bf16*)(ws + WS_SGY); bf16* KS = (bf16*)(ws + WS_KS);
#define ST8(ptr, a, b) do { u32x4v w_; w_.x = pkbf((a)[0], (a)[1]); w_.y = pkbf((a)[2], (a)[3]); w_.z = pkbf((b)[0], (b)[1]); w_.w = pkbf((b)[2], (b)[3]); *(u32x4v*)(ptr) = w_; } while (0)
        if (mode == EM_CONV) {
            if (u.pn < 32) {
                const int col = u.pn * 64 + wc * 16 + fq * 4;
#pragma unroll
                for (int ai = 0; ai < 2; ++ai)
#pragma unroll
                    for (int m = 0; m < 4; ++m) { const int row = row0 + ai * 128 + m * 16; const float rs = rstd[row];
                        const f32x4 bg = acc[ai][0][m][0] * rs, cgv = acc[ai][0][m][1] * rs, uu = acc[ai][1][m][0] * rs, gt = acc[ai][1][m][1] * rs;
                        const f32x4 z = cgv * uu; f32x4 b; b[0] = bg[0] * silu_f(gt[0]); b[1] = bg[1] * silu_f(gt[1]); b[2] = bg[2] * silu_f(gt[2]); b[3] = bg[3] * silu_f(gt[3]);
                        u32x2 zz; zz.x = pkbf(z[0], z[1]); zz.y = pkbf(z[2], z[3]); *(u32x2*)(RQ + (size_t)row * BR + col) = zz;
                        u32x2 bb; bb.x = pkbf(b[0], b[1]); bb.y = pkbf(b[2], b[3]); *(u32x2*)(SGY + (size_t)row * GWID + col) = bb; }
            } else {
                const int col = (u.pn - 32) * 128 + tc8;
#pragma unroll
                for (int ai = 0; ai < 2; ++ai)
#pragma unroll
                    for (int m = 0; m < 4; ++m) { const int row = row0 + ai * 128 + m * 16; const float rs = rstd[row]; const float rq = rs * C2;
                        const f32x4 q0 = acc[ai][0][m][0] * rq, q1 = acc[ai][0][m][1] * rq; ST8(QM + (size_t)row * QMW + col, q0, q1);
                        f32x4 g0 = acc[ai][1][m][0] * rs, g1 = acc[ai][1][m][1] * rs;
#pragma unroll
                        for (int j = 0; j < 4; ++j) { g0[j] = silu_f(g0[j]); g1[j] = silu_f(g1[j]); }
                        ST8(SGY + (size_t)row * GWID + BR + col, g0, g1); }
            }
        } else if (mode == EM_DIFF1 || mode == EM_SWA) {
            bf16* dst; int pitch; float sc = 1.f; int act = 0; const int pn = u.pn;
            if (pn < 8) { dst = RQ + pn * 256; pitch = BR; sc = C2; }
            else if (mode == EM_DIFF1) { if (pn < 16) { dst = RK + (pn - 8) * 256; pitch = BR; } else { dst = QM; pitch = QMW; sc = C2; } }
            else { if (pn == 8) { dst = KS; pitch = 256; } else if (pn == 9) { dst = QM; pitch = QMW; sc = C2; } else { dst = SGY + (pn - 10) * 256; pitch = GWID; act = 1; } }
#pragma unroll
            for (int ai = 0; ai < 2; ++ai)
#pragma unroll
                for (int m = 0; m < 4; ++m) { const int row = row0 + ai * 128 + m * 16; const float rs = rstd[row] * sc;
#pragma unroll
                    for (int bj = 0; bj < 2; ++bj) { f32x4 v0 = acc[ai][bj][m][0] * rs, v1 = acc[ai][bj][m][1] * rs;
                        if (act) {
#pragma unroll
                            for (int j = 0; j < 4; ++j) { v0[j] = silu_f(v0[j]); v1[j] = silu_f(v1[j]); } }
                        ST8(dst + (size_t)row * pitch + bj * 128 + tc8, v0, v1); } }
        } else if (mode == EM_VT) {
#pragma unroll
            for (int bj = 0; bj < 2; ++bj) { const int col = u.pn * 256 + bj * 128 + tc8; f32x4 r0 = {1.f, 1.f, 1.f, 1.f}, r1 = r0;
                if (rstd) { r0 = *(const f32x4*)(rstd + col); r1 = *(const f32x4*)(rstd + col + 4); }
                const int p0 = col - (fq & 1) * 8 + (fq & 1) * 4;
#pragma unroll
                for (int ai = 0; ai < 2; ++ai)
#pragma unroll
                    for (int m = 0; m < 4; ++m) { const int row = row0 + ai * 128 + m * 16; const f32x4 v0 = acc[ai][bj][m][0] * r0, v1 = acc[ai][bj][m][1] * r1;
                        u32x2 a_, b_; a_.x = pkbf(v0[0], v0[1]); a_.y = pkbf(v0[2], v0[3]); b_.x = pkbf(v1[0], v1[1]); b_.y = pkbf(v1[2], v1[3]);
                        *(u32x2*)(o0 + (size_t)row * ldc + p0) = a_; *(u32x2*)(o0 + (size_t)row * ldc + p0 + 8) = b_; } }
        } else if (mode == EM_GATE) {
            const int pn = u.pn; const bf16* src; int sp; if (pn < 8) { src = RQ + pn * 256; sp = BR; } else { src = QM; sp = QMW; }
            bf16* dst = SGY + pn * 256;
#pragma unroll
            for (int ai = 0; ai < 2; ++ai)
#pragma unroll
                for (int m = 0; m < 4; ++m) { const int row = row0 + ai * 128 + m * 16; const float rs = rstd[row];
#pragma unroll
                    for (int bj = 0; bj < 2; ++bj) { f32x4 v0 = acc[ai][bj][m][0] * rs, v1 = acc[ai][bj][m][1] * rs;
                        const u32x4v mx = *(const u32x4v*)(src + (size_t)row * sp + bj * 128 + tc8);
                        v0[0] = silu_f(v0[0]) * bf_lo(mx.x); v0[1] = silu_f(v0[1]) * bf_hi(mx.x); v0[2] = silu_f(v0[2]) * bf_lo(mx.y); v0[3] = silu_f(v0[3]) * bf_hi(mx.y);
                        v1[0] = silu_f(v1[0]) * bf_lo(mx.z); v1[1] = silu_f(v1[1]) * bf_hi(mx.z); v1[2] = silu_f(v1[2]) * bf_lo(mx.w); v1[3] = silu_f(v1[3]) * bf_hi(mx.w);
                        ST8(dst + (size_t)row * GWID + bj * 128 + tc8, v0, v1); } }
        } else if (mode == EM_PLAIN) {
#pragma unroll
            for (int ai = 0; ai < 2; ++ai)
#pragma unroll
                for (int m = 0; m < 4; ++m) { const int row = row0 + ai * 128 + m * 16;
#pragma unroll
                    for (int bj = 0; bj < 2; ++bj) ST8(o0 + (size_t)row * ldc + u.pn * 256 + bj * 128 + tc8, acc[ai][bj][m][0], acc[ai][bj][m][1]); }
        } else {
            float* YO = (float*)(ws + WS_RQ);
#pragma unroll
            for (int ai = 0; ai < 2; ++ai)
#pragma unroll
                for (int m = 0; m < 4; ++m) { const int row = row0 + ai * 128 + m * 16; float q = 0.f;
#pragma unroll
                    for (int bj = 0; bj < 2; ++bj) { const f32x4 v0 = acc[ai][bj][m][0], v1 = acc[ai][bj][m][1];
                        float* p = YO + (size_t)row * D + u.pn * 256 + bj * 128 + tc8; *(f32x4*)p = v0; *(f32x4*)(p + 4) = v1;
                        q += (v0[0] * v0[0] + v0[1] * v0[1]) + (v0[2] * v0[2] + v0[3] * v0[3]) + (v1[0] * v1[0] + v1[1] * v1[1]) + (v1[2] * v1[2] + v1[3] * v1[3]); }
                    q += __shfl_xor(q, 16); q += __shfl_xor(q, 32);
                    if (fq == 0) ss[(size_t)row * 16 + u.pn * 4 + wc] = q; }
        }
#undef ST8
    }
};
struct OneUnit { int has;
    __device__ __forceinline__ bool next(int i, pg8::Unit& u) const { if (i > 0 || !has) return false; u.pm = 0; u.pn = 0; return true; }
    __device__ __forceinline__ void a_ready(const pg8::Unit&) const {}
    __device__ __forceinline__ void done(const pg8::Unit&) const {} };

struct Args { const void* in[35]; float* out; unsigned char* ws; int ph_lo, ph_hi; };
struct Frame { LAS unsigned char* lds; int tid, lane, wave, G, bx, gw, NGW; unsigned char* ws; };
__device__ __forceinline__ void frame_refresh(Frame& F) { int t = threadIdx.x; asm volatile("" : "+v"(t)); F.tid = t; F.lane = t & 63; F.wave = __builtin_amdgcn_readfirstlane(t >> 6); F.gw = F.bx * NWAVES + F.wave; }

__device__ __forceinline__ float wave_sum(float v) {
#pragma unroll
    for (int o = 1; o < 64; o <<= 1) v += __shfl_xor(v, o);
    return v;
}
__device__ __forceinline__ int win_srccol(int kind, int n) {
    if (kind == 0) {
        const int pn = n >> 8, tc = n & 255;
        if (pn < 32) { const int bj = tc >> 7, wc = (tc >> 5) & 3, i = tc & 31, fq = i >> 3, nn = (i >> 2) & 1, j = i & 3, s = 2 * bj + nn;
            const int base = (s == 0) ? 0 : (s == 1) ? 2048 : (s == 2) ? 4096 : 6400; return base + pn * 64 + wc * 16 + fq * 4 + j; }
        const int t = pn - 32, bj = tc >> 7, c = tc & 127; return (bj == 0 ? 6144 : 6400 + 2048) + t * 128 + c;
    } else if (kind == 1) {
        if (n < 4096) return n; if (n < 4352) return 6144 + (n - 4096); if (n < 6400) return 4096 + (n - 4352); return n;
    } else {
        if (n < 2304) return n; if (n < 2560) return 2560 + (n - 2304); if (n < 4864) return 2816 + (n - 2560); return 2304 + (n - 4864);
    }
}
__device__ __forceinline__ void transpose_item(const float* W, int K, int Nsrc, const float* gain, int mapmode, bf16* WT, LAS float* scr, int item, int nblk, int lane) {
    const int kb = item / nblk, nb = item % nblk, k0 = 64 * kb, n0 = 32 * nb;
    const int nd = n0 + (lane & 31); const int sc = (mapmode < 0) ? nd : win_srccol(mapmode, nd);
#pragma unroll 8
    for (int i = 0; i < 32; ++i) { const int kk = 2 * i + (lane >> 5); float v = W[(size_t)(k0 + kk) * Nsrc + sc]; if (gain) v *= gain[k0 + kk]; scr[kk * 33 + (lane & 31)] = v; }
    LDS_WAIT(); asm volatile("" ::: "memory");
    const int c = lane & 7;
#pragma unroll
    for (int j = 0; j < 4; ++j) { const int n = (lane >> 3) + 8 * j; const LAS float* s = scr + (8 * c) * 33 + n;
        v4u o; o.x = pk2(s[0 * 33], s[1 * 33]); o.y = pk2(s[2 * 33], s[3 * 33]); o.z = pk2(s[4 * 33], s[5 * 33]); o.w = pk2(s[6 * 33], s[7 * 33]);
        *(GAS v4u*)(WT + (size_t)(n0 + n) * K + k0 + 8 * c) = o; }
    LDS_WAIT(); asm volatile("" ::: "memory");
}

__device__ __forceinline__ void prep_phase(Frame& F, const Args& a, int L) {
    float* rstd = (float*)(F.ws + WS_RSTD); float* ss = (float*)(F.ws + WS_QM); bf16* XB = (bf16*)(F.ws + WS_XB); const float* YO = (const float*)(F.ws + WS_RQ);
    const int base_prev = (L == 1) ? 3 : (L == 2) ? 10 : (L == 3) ? 21 : 28;
    const float* gpost = (L > 0) ? (const float*)a.in[base_prev + 1] : nullptr;
    const float* xin = (L <= 1) ? (const float*)a.in[0] : a.out;
    for (int m = F.gw; m < M; m += F.NGW) {
        const GAS f32x4* xr = (const GAS f32x4*)(xin + (size_t)m * D) + F.lane;
        f32x4 v[4];
#pragma unroll
        for (int j = 0; j < 4; ++j) v[j] = xr[64 * j];
        if (L > 0) {
            float ssum = 0.f; { const f32x4* sp = (const f32x4*)(ss + (size_t)m * 16); const f32x4 a0 = sp[0], a1 = sp[1], a2 = sp[2], a3 = sp[3];
                ssum = ((a0.x + a0.y) + (a0.z + a0.w)) + ((a1.x + a1.y) + (a1.z + a1.w)) + ((a2.x + a2.y) + (a2.z + a2.w)) + ((a3.x + a3.y) + (a3.z + a3.w)); }
            const float r = 1.0f / sqrtf(ssum * (1.0f / D) + EPS);
            const GAS f32x4* yr = (const GAS f32x4*)(YO + (size_t)m * D) + F.lane; const GAS f32x4* gp = (const GAS f32x4*)gpost + F.lane;
#pragma unroll
            for (int j = 0; j < 4; ++j) { const f32x4 y = yr[64 * j], g = gp[64 * j]; v[j] = v[j] + y * g * r; }
            GAS f32x4* xo = (GAS f32x4*)(a.out + (size_t)m * D) + F.lane;
#pragma unroll
            for (int j = 0; j < 4; ++j) xo[64 * j] = v[j];
        }
        if (L < 4) {
            float s2 = 0.f;
#pragma unroll
            for (int j = 0; j < 4; ++j) s2 += (v[j].x * v[j].x + v[j].y * v[j].y) + (v[j].z * v[j].z + v[j].w * v[j].w);
            s2 = wave_sum(s2);
            GAS unsigned long long* o8 = (GAS unsigned long long*)(XB + (size_t)m * D) + F.lane;
#pragma unroll
            for (int j = 0; j < 4; ++j) o8[64 * j] = (unsigned long long)pk2(v[j].x, v[j].y) | ((unsigned long long)pk2(v[j].z, v[j].w) << 32);
            if (F.lane == 0) rstd[m] = 1.0f / sqrtf(s2 * (1.0f / D) + EPS);
        }
    }
    if (L >= 4) return;
    const int base = (L == 0) ? 3 : (L == 1) ? 10 : (L == 2) ? 21 : 28; const int kind = (L == 3) ? 0 : L;
    const float* gpre = (const float*)a.in[base]; const float* gmem = (const float*)a.in[base + 2];
    const float* w_in = (const float*)a.in[base + 3]; const float* w_mem = (const float*)a.in[base + 4];
    const float* w_out = (const float*)a.in[(L == 0) ? 9 : (L == 1) ? 20 : (L == 2) ? 27 : 34];
    const int NIN = (kind == 2) ? 5120 : 8704;
    bf16* MEMN = (bf16*)(F.ws + WS_MEMN);
    for (int m = F.gw; m < 256; m += F.NGW) {
        const GAS f32x4* xr = (const GAS f32x4*)((const float*)a.in[1] + (size_t)m * D) + F.lane; const GAS f32x4* gp = (const GAS f32x4*)gmem + F.lane;
        f32x4 v[4]; float s2 = 0.f;
#pragma unroll
        for (int j = 0; j < 4; ++j) { v[j] = xr[64 * j]; s2 += (v[j].x * v[j].x + v[j].y * v[j].y) + (v[j].z * v[j].z + v[j].w * v[j].w); }
        const float r = 1.0f / sqrtf(wave_sum(s2) * (1.0f / D) + EPS);
        GAS unsigned long long* o8 = (GAS unsigned long long*)(MEMN + (size_t)m * D) + F.lane;
#pragma unroll
        for (int j = 0; j < 4; ++j) { const f32x4 g = gp[64 * j]; const f32x4 t = v[j] * g * r; o8[64 * j] = (unsigned long long)pk2(t.x, t.y) | ((unsigned long long)pk2(t.z, t.w) << 32); }
    }
    LAS float* scr = (LAS float*)(F.lds + F.wave * 16384);
    const int I_IN = (D / 64) * (NIN / 32), I_OUT = (GWID / 64) * (D / 32), I_MEM = (D / 64) * (512 / 32);
    for (int it = F.gw; it < I_IN + I_OUT + I_MEM; it += F.NGW) {
        int r = it;
        if (r < I_IN) { transpose_item(w_in, D, NIN, gpre, kind, (bf16*)(F.ws + WS_WIN), scr, r, NIN / 32, F.lane); continue; } r -= I_IN;
        if (r < I_OUT) { transpose_item(w_out, GWID, D, nullptr, -1, (bf16*)(F.ws + WS_WOUT), scr, r, D / 32, F.lane); continue; } r -= I_OUT;
        transpose_item(w_mem, D, 512, nullptr, -1, (bf16*)(F.ws + WS_WMEM), scr, r, 512 / 32, F.lane);
    }
}

__device__ __forceinline__ void conv_phase(Frame& F, const float* convw) {
    const bf16* Z = (const bf16*)(F.ws + WS_RQ); bf16* SGY = (bf16*)(F.ws + WS_SGY);
    const int nthreads = F.G * 512; const int gt = F.bx * 512 + F.tid;
    for (int task = gt; task < 256 * 512; task += nthreads) {
        const int cc = (task & 255) * 8, t0 = (task >> 8) * 32;
        float w0[8], w1[8], w2[8];
#pragma unroll
        for (int j = 0; j < 8; ++j) { w0[j] = convw[cc + j]; w1[j] = convw[BR + cc + j]; w2[j] = convw[2 * BR + cc + j]; }
        float za[8], zb[8];
        if (t0 >= 2) { const v4u a = *(const v4u*)(Z + (size_t)(t0 - 2) * BR + cc), b = *(const v4u*)(Z + (size_t)(t0 - 1) * BR + cc);
            za[0] = bf_lo(a.x); za[1] = bf_hi(a.x); za[2] = bf_lo(a.y); za[3] = bf_hi(a.y); za[4] = bf_lo(a.z); za[5] = bf_hi(a.z); za[6] = bf_lo(a.w); za[7] = bf_hi(a.w);
            zb[0] = bf_lo(b.x); zb[1] = bf_hi(b.x); zb[2] = bf_lo(b.y); zb[3] = bf_hi(b.y); zb[4] = bf_lo(b.z); zb[5] = bf_hi(b.z); zb[6] = bf_lo(b.w); zb[7] = bf_hi(b.w);
        } else {
#pragma unroll
            for (int j = 0; j < 8; ++j) { za[j] = 0.f; zb[j] = 0.f; } }
#pragma unroll 4
        for (int t = t0; t < t0 + 32; ++t) {
            const v4u c = *(const v4u*)(Z + (size_t)t * BR + cc); const v4u g = *(const v4u*)(SGY + (size_t)t * GWID + cc);
            float zc[8], gg[8];
            zc[0] = bf_lo(c.x); zc[1] = bf_hi(c.x); zc[2] = bf_lo(c.y); zc[3] = bf_hi(c.y); zc[4] = bf_lo(c.z); zc[5] = bf_hi(c.z); zc[6] = bf_lo(c.w); zc[7] = bf_hi(c.w);
            gg[0] = bf_lo(g.x); gg[1] = bf_hi(g.x); gg[2] = bf_lo(g.y); gg[3] = bf_hi(g.y); gg[4] = bf_lo(g.z); gg[5] = bf_hi(g.z); gg[6] = bf_lo(g.w); gg[7] = bf_hi(g.w);
            float o[8];
#pragma unroll
            for (int j = 0; j < 8; ++j) { o[j] = gg[j] * (w0[j] * za[j] + w1[j] * zb[j] + w2[j] * zc[j]); za[j] = zb[j]; zb[j] = zc[j]; }
            v4u w; w.x = pkbf(o[0], o[1]); w.y = pkbf(o[2], o[3]); w.z = pkbf(o[4], o[5]); w.w = pkbf(o[6], o[7]);
            *(v4u*)(SGY + (size_t)t * GWID + cc) = w;
        }
    }
}

template <int MODE, bool OUTMUL>
__device__ __forceinline__ void attn256_task(const bf16* Qp, int qpitch, const bf16* Kp, int kpitch, int krow0, const bf16* Vtp, int vpitch, bf16* Op, int opitch,
                                             const int* pos, int prow0, float sl2, float sink2, int lane) {
    const int r32 = lane & 31, hi = lane >> 5;
    bf16x8 qf[4];
#pragma unroll
    for (int d0 = 0; d0 < 4; ++d0) qf[d0] = *(const bf16x8*)(Qp + (size_t)r32 * qpitch + d0 * 16 + hi * 8);
    float mrun = (MODE == 1) ? sink2 : NEGBIG, den = 0.f; int pq = 0; if (MODE == 1) pq = pos[prow0 + r32];
    f32x16 o[2]; o[0] = (f32x16){}; o[1] = (f32x16){};
#pragma unroll
    for (int hb = 0; hb < 2; ++hb) {
        f32x16 s[4];
#pragma unroll
        for (int kq = 0; kq < 4; ++kq) { const int kb = 4 * hb + kq;
            int kr = krow0 + 32 * kb + r32; if (MODE == 1 && kr < 0) kr = 0;
            const bf16* kp = Kp + (size_t)kr * kpitch + hi * 8;
            f32x16 accv = {};
#pragma unroll
            for (int d0 = 0; d0 < 4; ++d0) { const bf16x8 kf = *(const bf16x8*)(kp + d0 * 16); accv = __builtin_amdgcn_mfma_f32_32x32x16_bf16(kf, qf[d0], accv, 0, 0, 0); }
            s[kq] = accv; __builtin_amdgcn_sched_barrier(0);
        }
        float mx = NEGBIG;
        if (MODE == 1) {
#pragma unroll
            for (int kq = 0; kq < 4; ++kq)
#pragma unroll
                for (int g = 0; g < 4; ++g) { const int sidx = 32 * (4 * hb + kq) + 8 * g + 4 * hi; int kr = krow0 + sidx; const bool kvalid = kr >= 0; if (kr < 0) kr = 0;
                    const i32x4 pk = *(const i32x4*)(pos + kr);
#pragma unroll
                    for (int j = 0; j < 4; ++j) { const int rel = pq - pk[j]; const bool ok = kvalid && rel >= 0 && rel < 128;
                        const float v = ok ? (s[kq][4 * g + j] - sl2 * (float)rel) : NEGBIG; s[kq][4 * g + j] = v; mx = fmaxf(mx, v); } }
        } else {
#pragma unroll
            for (int kq = 0; kq < 4; ++kq)
#pragma unroll
                for (int r = 0; r < 16; ++r) mx = fmaxf(mx, s[kq][r]);
        }
        mx = fmaxf(mx, __shfl_xor(mx, 32));
        const float mnew = fmaxf(mrun, mx), al = __builtin_amdgcn_exp2f(mrun - mnew); mrun = mnew; den *= al; o[0] *= al; o[1] *= al;
#pragma unroll
        for (int kq = 0; kq < 4; ++kq)
#pragma unroll
            for (int r = 0; r < 16; ++r) { const float p = __builtin_amdgcn_exp2f(s[kq][r] - mnew); s[kq][r] = p; den += p; }
        __builtin_amdgcn_sched_barrier(0);
#pragma unroll
        for (int kq = 0; kq < 4; ++kq)
#pragma unroll
            for (int sh = 0; sh < 2; ++sh) { const int kb = 4 * hb + kq;
                v4u pw; pw.x = pkbf(s[kq][8 * sh + 0], s[kq][8 * sh + 1]); pw.y = pkbf(s[kq][8 * sh + 2], s[kq][8 * sh + 3]); pw.z = pkbf(s[kq][8 * sh + 4], s[kq][8 * sh + 5]); pw.w = pkbf(s[kq][8 * sh + 6], s[kq][8 * sh + 7]);
                const bf16x8 pb = __builtin_bit_cast(bf16x8, pw);
                int vc = krow0 + 32 * kb + 16 * sh + 8 * hi; if (MODE == 1 && vc < 0) vc = 0;
#pragma unroll
                for (int eb = 0; eb < 2; ++eb) { const bf16x8 av = *(const bf16x8*)(Vtp + (size_t)(32 * eb + r32) * vpitch + vc);
                    o[eb] = __builtin_amdgcn_mfma_f32_32x32x16_bf16(av, pb, o[eb], 0, 0, 0); }
                __builtin_amdgcn_sched_barrier(0);
            }
    }
    den += __shfl_xor(den, 32);
    if (MODE == 1) den += __builtin_amdgcn_exp2f(sink2 - mrun);
    const float inv = 1.0f / den;
#pragma unroll
    for (int eb = 0; eb < 2; ++eb)
#pragma unroll
        for (int g = 0; g < 4; ++g) { bf16* op = Op + (size_t)r32 * opitch + 32 * eb + 8 * g + 4 * hi;
            float v0 = o[eb][4 * g] * inv, v1 = o[eb][4 * g + 1] * inv, v2 = o[eb][4 * g + 2] * inv, v3 = o[eb][4 * g + 3] * inv;
            if (OUTMUL) { const u32x2 f = *(const u32x2*)op; v0 *= bf_lo(f.x); v1 *= bf_hi(f.x); v2 *= bf_lo(f.y); v3 *= bf_hi(f.y); }
            u32x2 w; w.x = pkbf(v0, v1); w.y = pkbf(v2, v3); *(u32x2*)op = w; }
}

template <bool OUTMUL> __device__ __forceinline__ void memattn_phase(Frame& F) {
    bf16* QM = (bf16*)(F.ws + WS_QM); const bf16* KM = (const bf16*)(F.ws + WS_KMEM); const bf16* VT = (const bf16*)(F.ws + WS_VMEMT); bf16* SGY = (bf16*)(F.ws + WS_SGY);
    for (int task = F.gw; task < 512 * 4; task += F.NGW) { const int hm = task & 3, rb = task >> 2, row0 = rb * 32;
        bf16* op = OUTMUL ? SGY + (size_t)row0 * GWID + BR + hm * 64 : QM + (size_t)row0 * QMW + hm * 64;
        attn256_task<0, OUTMUL>(QM + (size_t)row0 * QMW + hm * 64, QMW, KM + hm * 64, 256, 0, VT + (size_t)(hm * 64) * 256, 256, op, OUTMUL ? GWID : QMW, nullptr, 0, 0.f, 0.f, F.lane); }
}
__device__ __forceinline__ void swa_phase(Frame& F, const int* pos, const float* sinks) {
    const bf16* RQ = (const bf16*)(F.ws + WS_RQ); const bf16* KS = (const bf16*)(F.ws + WS_KS); const bf16* VTS = (const bf16*)(F.ws + WS_VTS); bf16* SGY = (bf16*)(F.ws + WS_SGY);
    for (int task = F.gw; task < 512 * 32; task += F.NGW) {
        const int qh = task & 31, rb = task >> 5, row0 = rb * 32, blk = rb >> 2, kvh = qh >> 3;
        const float slope = __builtin_amdgcn_exp2f(-8.0f * (float)(qh + 1) / 32.0f);
        attn256_task<1, true>(RQ + (size_t)row0 * BR + qh * 64, BR, KS + kvh * 64, 256, (blk - 1) * 128, VTS + (size_t)(kvh * 64) * M, M, SGY + (size_t)row0 * GWID + qh * 64, GWID,
                              pos, row0, slope * LOG2E, sinks[qh] * LOG2E, F.lane);
    }
}

constexpr int DA_KP = 272, DA_KB = 16384, DA_VB = 16384, DA_BUF = DA_KB + DA_VB + 256, DA_QOFF = 2 * DA_BUF;
__device__ __forceinline__ void diffattn_phase(Frame& F, const Args& a) {
    bf16* RQ = (bf16*)(F.ws + WS_RQ); const bf16* RK = (const bf16*)(F.ws + WS_RK); const bf16* RVT = (const bf16*)(F.ws + WS_RV);
    const int* pos = (const int*)a.in[2]; const float* subln = (const float*)a.in[19];
    const int tid = F.tid, lane = F.lane, w = F.wave, r32 = lane & 31, hi = lane >> 5;
    float lam;
    { const float p1 = ((const float*)a.in[15])[lane] * ((const float*)a.in[16])[lane], p2 = ((const float*)a.in[17])[lane] * ((const float*)a.in[18])[lane];
      lam = expf(wave_sum(p1)) - expf(wave_sum(p2)) + LAM_INIT; }
    for (int i = 0; i < 4; ++i) {
        const int L = i * F.G + F.bx; if (L >= 1024) break;
        const int v = L & 255, h = v >> 4, sidx = v & 15; const int qb = (i == 0) ? sidx : (i == 1) ? 31 - sidx : (i == 2) ? 32 + sidx : 63 - sidx;
        const float sl2 = __builtin_amdgcn_exp2f(-8.0f * (float)(h + 1) / 16.0f) * LOG2E;
        const int q0 = qb * 256 + w * 32;
        LAS unsigned char* Ql = F.lds + DA_QOFF + w * (32 * DA_KP);
#pragma unroll
        for (int ii = 0; ii < 8; ++ii) { const int id = lane + 64 * ii, qr_ = id >> 4, qc_ = id & 15;
            *(LAS v4u*)(Ql + qr_ * DA_KP + qc_ * 16) = *(const v4u*)(RQ + (size_t)(q0 + qr_) * BR + h * 128 + qc_ * 8); }
        const LAS unsigned char* Qrd = Ql + r32 * DA_KP + hi * 16;
        const float kq = sl2 * (float)pos[q0 + r32];
        float mrun[2] = {0.f, 0.f}, lrun[2] = {0.f, 0.f};
        f32x16 o[2][4];
#pragma unroll
        for (int c = 0; c < 2; ++c)
#pragma unroll
            for (int eb = 0; eb < 4; ++eb) o[c][eb] = (f32x16){};
        const int T_hi = 4 * qb + 3, t_mine = 4 * qb + (w >> 1);
        unsigned ksrc[2], vsrc[2];
#pragma unroll
        for (int p = 0; p < 2; ++p) { const int I = 2 * w + p; const int kr_ = 4 * I + (lane >> 4), kc_ = (lane & 15) ^ (kr_ & 15);
            ksrc[p] = (unsigned)(kr_ * BR + h * 128 + kc_ * 8);
            const int ve_ = 8 * I + (lane >> 3), vc_ = (lane & 7) ^ ((ve_ >> 1) & 7);
            vsrc[p] = (unsigned)((h * 128 + ve_) * M + vc_ * 8); }
#define DA_ISSUE(t, b) do { LAS unsigned char* B_ = F.lds + (b) * DA_BUF; \
        __builtin_amdgcn_global_load_lds((const unsigned*)(RK + (size_t)(ksrc[0] + (unsigned)(t) * 64u * BR)), (LAS unsigned*)(B_ + (2 * w) * 1024), 16, 0, 0); \
        __builtin_amdgcn_global_load_lds((const unsigned*)(RK + (size_t)(ksrc[1] + (unsigned)(t) * 64u * BR)), (LAS unsigned*)(B_ + (2 * w + 1) * 1024), 16, 0, 0); \
        __builtin_amdgcn_global_load_lds((const unsigned*)(RVT + (size_t)(vsrc[0] + (unsigned)(t) * 64u)), (LAS unsigned*)(B_ + DA_KB + (2 * w) * 1024), 16, 0, 0); \
        __builtin_amdgcn_global_load_lds((const unsigned*)(RVT + (size_t)(vsrc[1] + (unsigned)(t) * 64u)), (LAS unsigned*)(B_ + DA_KB + (2 * w + 1) * 1024), 16, 0, 0); \
        if (tid < 64) *(LAS float*)(B_ + DA_KB + DA_VB + tid * 4) = sl2 * (float)pos[(t) * 64 + tid]; } while (0)
        DA_ISSUE(T_hi, 0); asm volatile("s_waitcnt vmcnt(0) lgkmcnt(0)" ::: "memory"); __syncthreads();
        int b = 0;
        const int ksw = (r32 & 15), vsw = (r32 >> 1) & 7;
        for (int t = T_hi; t >= 0; --t, b ^= 1) {
            if (t > 0) DA_ISSUE(t - 1, b ^ 1);
            if (t <= t_mine) {
                const LAS unsigned char* Kl = F.lds + b * DA_BUF; const LAS unsigned char* Vl = Kl + DA_KB; const LAS float* kbf = (const LAS float*)(Kl + DA_KB + DA_VB);
                const bool need_mask = (t * 64 + 63 > q0);
#pragma unroll
                for (int c = 0; c < 2; ++c) {
#pragma unroll
                  for (int kvb = 0; kvb < 2; ++kvb) {
                    if (t * 64 + 32 * kvb > q0 + 31) continue;
                    const bool fst = (t == t_mine) && (kvb == 0);
                    f32x16 s0; const float cm = -kq - mrun[c];
#pragma unroll
                    for (int g = 0; g < 4; ++g) { const f32x4 k0 = *(const LAS f32x4*)(kbf + 32 * kvb + 8 * g + 4 * hi);
#pragma unroll
                        for (int j = 0; j < 4; ++j) { float v_ = k0[j] + cm; if (need_mask && k0[j] > kq) v_ = NEGBIG; s0[4 * g + j] = v_; } }
                    __builtin_amdgcn_sched_barrier(0);
#pragma unroll
                    for (int d0 = 0; d0 < 4; ++d0) { const int ch = ((8 * c + 2 * d0 + hi) ^ ksw) * 16;
                        const bf16x8 ka = *(const LAS bf16x8*)(Kl + (32 * kvb + r32) * 256 + ch);
                        const bf16x8 qv = *(const LAS bf16x8*)(Qrd + (c * 64 + d0 * 16) * 2);
                        s0 = __builtin_amdgcn_mfma_f32_32x32x16_bf16(ka, qv, s0, 0, 0, 0); }
                    __builtin_amdgcn_sched_barrier(0);
                    float mx = s0[0];
#pragma unroll
                    for (int r = 1; r < 16; ++r) mx = fmaxf(mx, s0[r]);
                    mx = fmaxf(mx, __shfl_xor(mx, 32));
                    if (fst || __any(mx > 8.0f)) {
                        const float dl = fst ? mx : fmaxf(mx, 0.f); mrun[c] += dl; const float al = __builtin_amdgcn_exp2f(-dl); lrun[c] *= al;
#pragma unroll
                        for (int r = 0; r < 16; ++r) s0[r] -= dl;
#pragma unroll
                        for (int eb = 0; eb < 4; ++eb) o[c][eb] *= al;
                    }
                    float ls = 0.f;
#pragma unroll
                    for (int r = 0; r < 16; ++r) { s0[r] = __builtin_amdgcn_exp2f(s0[r]); ls += s0[r]; }
                    lrun[c] += ls;
                    __builtin_amdgcn_sched_barrier(0);
#pragma unroll
                    for (int sh = 0; sh < 2; ++sh) { const int ks = 2 * kvb + sh;
                        v4u pw; pw.x = pkbf(s0[8 * sh + 0], s0[8 * sh + 1]); pw.y = pkbf(s0[8 * sh + 2], s0[8 * sh + 3]); pw.z = pkbf(s0[8 * sh + 4], s0[8 * sh + 5]); pw.w = pkbf(s0[8 * sh + 6], s0[8 * sh + 7]);
                        const bf16x8 pb = __builtin_bit_cast(bf16x8, pw); const int vch = ((2 * ks + hi) ^ vsw) * 16;
#pragma unroll
                        for (int eb = 0; eb < 4; ++eb) { const bf16x8 av = *(const LAS bf16x8*)(Vl + (32 * eb + r32) * 128 + vch);
                            o[c][eb] = __builtin_amdgcn_mfma_f32_32x32x16_bf16(av, pb, o[c][eb], 0, 0, 0); }
                        __builtin_amdgcn_sched_barrier(0);
                    }
                  }
                }
            }
            asm volatile("s_waitcnt vmcnt(0) lgkmcnt(0)" ::: "memory"); __syncthreads();
        }
#undef DA_ISSUE
        const float l0 = lrun[0] + __shfl_xor(lrun[0], 32), l1 = lrun[1] + __shfl_xor(lrun[1], 32);
        const float i0 = 1.0f / l0, i1 = lam / l1; float sq = 0.f;
#pragma unroll
        for (int eb = 0; eb < 4; ++eb)
#pragma unroll
            for (int r = 0; r < 16; ++r) { const float v2 = o[0][eb][r] * i0 - o[1][eb][r] * i1; o[0][eb][r] = v2; sq += v2 * v2; }
        sq += __shfl_xor(sq, 32);
        const float rn = (1.0f / sqrtf(sq * (1.0f / 128.0f) + EPS)) * (1.0f - LAM_INIT);
#pragma unroll
        for (int eb = 0; eb < 4; ++eb)
#pragma unroll
            for (int g = 0; g < 4; ++g) { const int e = 32 * eb + 8 * g + 4 * hi; const f32x4 sg = *(const f32x4*)(subln + e);
                u32x2 wv; wv.x = pkbf(o[0][eb][4 * g] * rn * sg[0], o[0][eb][4 * g + 1] * rn * sg[1]); wv.y = pkbf(o[0][eb][4 * g + 2] * rn * sg[2], o[0][eb][4 * g + 3] * rn * sg[3]);
                *(u32x2*)(RQ + (size_t)(q0 + r32) * BR + h * 128 + e) = wv; }
    }
}

struct Sched2 { pg8::StaticOrder so; int one, mine;
    __device__ __forceinline__ bool next(int i, pg8::Unit& u) const { if (one) { if (i > 0 || !mine) return false; u.pm = 0; u.pn = 0; return true; } return so.next(i, u); }
    __device__ __forceinline__ void a_ready(const pg8::Unit&) const {}
    __device__ __forceinline__ void done(const pg8::Unit&) const {} };

__global__ void __launch_bounds__(NWAVES * 64, 2) mega_fwd(Args args) {
    extern __shared__ __attribute__((aligned(16))) unsigned char lds_raw[];
    Frame F; F.lds = (LAS unsigned char*)lds_raw; F.tid = threadIdx.x; F.lane = F.tid & 63; F.wave = __builtin_amdgcn_readfirstlane(F.tid >> 6);
    F.G = gridDim.x; F.bx = blockIdx.x; F.gw = F.bx * NWAVES + F.wave; F.NGW = F.G * NWAVES; F.ws = args.ws;
    volatile LAS unsigned* MISC = (volatile LAS unsigned*)(F.lds + MISC_OFF);
    if (F.tid < 32) ((LAS unsigned*)(F.lds + MISC_OFF))[F.tid] = 0u;
    __syncthreads();
    const bool single = (args.ph_hi - args.ph_lo) > 1;
    XcdBarrier bar; bar.bar = (unsigned*)(F.ws + WS_BAR); bar.x = 0; bar.st = nullptr;
    if (single) bar = xcd_barrier_post((unsigned*)(F.ws + WS_BAR), MISC + 8);
    const float* rstd = (const float*)(F.ws + WS_RSTD); float* ss = (float*)(F.ws + WS_QM);
    const bf16* XB = (const bf16*)(F.ws + WS_XB); const bf16* WIN = (const bf16*)(F.ws + WS_WIN); const bf16* WOUT = (const bf16*)(F.ws + WS_WOUT); const bf16* WMEM = (const bf16*)(F.ws + WS_WMEM);
    const bf16* MEMN = (const bf16*)(F.ws + WS_MEMN);
    int ph = 0;
    for (int L = 0; L <= 4; ++L) {
        const int kind = (L == 3) ? 0 : L;
        const int nsub = (L == 4) ? 1 : (kind == 1) ? 5 : 4;
        for (int sub = 0; sub < nsub; ++sub, ++ph) {
            if (ph < args.ph_lo || ph >= args.ph_hi) continue;
            frame_refresh(F);
            int op = sub; if (kind != 1 && sub == 3) op = 4;
            if (op == 0) prep_phase(F, args, L);
            else if (op == 2) {
                if (kind == 0) { conv_phase(F, (const float*)args.in[(L == 0) ? 8 : 33]); memattn_phase<true>(F); }
                else if (kind == 1) { diffattn_phase(F, args); memattn_phase<false>(F); }
                else { swa_phase(F, (const int*)args.in[2], (const float*)args.in[26]); memattn_phase<true>(F); }
            } else {
                for (int j = 0; j < 4; ++j) {
                    Epi E{}; E.rstd = rstd; E.ws = F.ws; E.ss = ss; E.ldc = 256;
                    const bf16* A = XB; const bf16* Bt = WIN; int Mg = M, Ng = 0, Kg = D, one = 0, mine = 0; bool valid = true;
                    if (op == 1) {
                        const int nmain = (kind == 0) ? 1 : 2;
                        if (j == 0) { E.mode = (kind == 0) ? EM_CONV : (kind == 1) ? EM_DIFF1 : EM_SWA; Ng = (kind == 0) ? 8704 : (kind == 1) ? 4352 : 4864; }
                        else if (j < nmain) { E.mode = EM_VT; E.ldc = M; Bt = XB; Ng = M;
                            if (kind == 1) { A = WIN + (size_t)4352 * D; Mg = 2048; E.o0 = (bf16*)(F.ws + WS_RV); } else { A = WIN + (size_t)4864 * D; Mg = 256; E.o0 = (bf16*)(F.ws + WS_VTS); } }
                        else if (j == nmain) { E.mode = EM_PLAIN; A = MEMN; Bt = WMEM; Mg = 256; Ng = 256; one = 1; mine = (F.bx == F.G - 1); E.o0 = (bf16*)(F.ws + WS_KMEM); }
                        else if (j == nmain + 1) { E.mode = EM_VT; E.rstd = nullptr; A = WMEM + (size_t)256 * D; Bt = MEMN; Mg = 256; Ng = 256; one = 1; mine = (F.bx == F.G - 2); E.o0 = (bf16*)(F.ws + WS_VMEMT); }
                        else valid = false;
                    } else if (op == 3) { if (j == 0) { E.mode = EM_GATE; Bt = WIN + (size_t)6400 * D; Ng = GWID; } else valid = false; }
                    else { if (j == 0) { E.mode = EM_OUT; A = (const bf16*)(F.ws + WS_SGY); Bt = WOUT; Ng = D; Kg = GWID; } else valid = false; }
                    if (!valid) break;
                    pg8::Gemm g{A, Bt, Mg, Ng, Kg}; Sched2 S; S.so.init(Mg, Ng, F.G, F.bx); S.one = one; S.mine = mine;
                    pg8::gemm_phase<Epi, Sched2, true, true>(F.lds, g, S, E);
                }
            }
            if (single && ph + 1 < args.ph_hi) { if (ph == args.ph_lo) { __threadfence(); cg::this_grid().sync(); } else xcd_barrier(bar); }
        }
    }
}

constexpr int N_PHASES = 18;
#ifndef MK_PER_PHASE
#define MK_PER_PHASE 0
#endif
extern "C" void kernel_launch(void* const* d_in, const int* in_sizes, int n_in, void* d_out, int out_size, void* d_ws, size_t ws_size, hipStream_t stream) {
    static int ready = 0;
    if (!ready) {
        if (n_in != 35 || out_size != M * D || ws_size < WS_END) { fprintf(stderr, "kernel_launch: unexpected shapes (n_in %d out %d ws %zu)\n", n_in, out_size, ws_size); ready = -1; return; }
        if (hipFuncSetAttribute((const void*)mega_fwd, hipFuncAttributeMaxDynamicSharedMemorySize, LDS_BYTES) != hipSuccess) { fprintf(stderr, "hipFuncSetAttribute failed\n"); ready = -1; return; }
        ready = 1;
    }
    if (ready < 0) return;
    (void)hipMemsetAsync((char*)d_ws + WS_BAR, 0, 64 * KiB, stream);
    Args a{};
    for (int i = 0; i < 35; ++i) a.in[i] = d_in[i];
    a.out = (float*)d_out; a.ws = (unsigned char*)d_ws;
    const int grid = 256;
#if MK_PER_PHASE
    for (int p = 0; p < N_PHASES; ++p) { a.ph_lo = p; a.ph_hi = p + 1; hipLaunchKernelGGL(mega_fwd, dim3(grid), dim3(NWAVES * 64), LDS_BYTES, stream, a); }
#else
    a.ph_lo = 0; a.ph_hi = N_PHASES;
    void* kargs[] = {&a};
    hipError_t e = hipLaunchCooperativeKernel((const void*)mega_fwd, dim3(grid), dim3(NWAVES * 64), kargs, LDS_BYTES, stream);
    if (e != hipSuccess) fprintf(stderr, "cooperative launch failed: %s\n", hipGetErrorString(e));
#endif
}
```

```cpp
#include <hip/hip_runtime.h>
#include <hip/hip_cooperative_groups.h>
#include <cstdio>
#include <cstdint>
namespace cg = cooperative_groups;
namespace pg8 {
#define PG8_LAS __attribute__((address_space(3)))
typedef unsigned short bf16_t;
typedef short bf16x8 __attribute__((ext_vector_type(8)));
typedef float f32x4 __attribute__((ext_vector_type(4)));
typedef unsigned u32x4 __attribute__((ext_vector_type(4)));
constexpr int BM = 256, BK = 64, HALF = 128, HTB = HALF * BK * 2  , STAGE_BYTES = 8 * HTB, NXCD = 8, WGM = 8;

__host__ __device__ __forceinline__ int lds_byte(int r, int c) { const int st = (r >> 4) * 2 + (c >> 5), rr = r & 15, cc = c & 31, ob = rr * 64 + cc * 2; return st * 1024 + (ob ^ (((ob >> 9) & 1) << 5)); }
__host__ __device__ __forceinline__ void stage_rc(int b, int& R, int& C) { const int st = b / 1024, sb = b % 1024, swz = sb ^ (((sb >> 9) & 1) << 5); R = (st >> 1) * 16 + swz / 64; C = (st & 1) * 32 + (swz % 64) / 2; }
__host__ __device__ __forceinline__ int perm32(int rho) { const int n = rho >> 4, i = rho & 15; return 8 * (i >> 2) + 4 * n + (i & 3); }

struct Unit { int pm, pn; };
struct Gemm { const bf16_t* A; const bf16_t* Bt; int M, N, K; };

struct StaticOrder {
    int nM, nN, nwg, G, c;
    __host__ __device__ void init(int M, int N, int G_, int c_) { nM = M / BM; nN = N / BM; nwg = nM * nN; G = G_; c = c_; }
    __host__ __device__ bool next(int i, Unit& u) const {
        const long L = (long)i * G + c; if (L >= nwg) return false;
        int wgid = (int)L; { const int q = nwg / NXCD, r = nwg % NXCD, xcd = wgid % NXCD, off = wgid / NXCD; wgid = (xcd < r ? xcd * (q + 1) : r * (q + 1) + (xcd - r) * q) + off; }
        const int nig = WGM * nN, gid = wgid / nig, fm = gid * WGM, gsz = (nM - fm) < WGM ? (nM - fm) : WGM;
        u.pm = fm + ((wgid % nig) % gsz); u.pn = (wgid % nig) / gsz; return true;
    }
    __device__ __forceinline__ void a_ready(const Unit&) const {}
    __device__ __forceinline__ void done(const Unit&) const {}
};

__device__ __forceinline__ unsigned cvt_pk_bf16(float lo, float hi) { unsigned r; asm volatile("v_cvt_pk_bf16_f32 %0, %1, %2" : "=v"(r) : "v"(lo), "v"(hi)); return r; }
template <class Epi, class Sched, bool ALIGN_EPI = false, bool SP2 = false>
__device__ __forceinline__ void gemm_phase(PG8_LAS unsigned char* lds, const Gemm g, const Sched& S, const Epi& E) {
    int tid_ = threadIdx.x; asm volatile("" : "+v"(tid_)); const int tid = tid_, wid = __builtin_amdgcn_readfirstlane(tid >> 6), lane = tid & 63, wr = wid >> 2, wc = wid & 3, fr = lane & 15, fq = lane >> 4;
    const int K = g.K, nt = K / BK;
    unsigned voffA[2], voffB[2];
#pragma unroll
    for (int i = 0; i < 2; ++i) { int R, C; stage_rc(tid * 16 + i * 8192, R, C); const int Rb = Epi::PERM ? ((R & ~31) + perm32(R & 31)) : R;
        voffA[i] = (unsigned)(R * K + C) * 2u; voffB[i] = (unsigned)(Rb * K + C) * 2u; }
    const size_t kstep = (size_t)(BK * 2);
    const size_t hstep = (size_t)HALF * K * 2;
    const size_t tstep = 2 * hstep;
    const unsigned ldsw = (unsigned)wid * 1024u;
    const int aoff = lds_byte(wr * 64 + fr, fq * 8), boff = lds_byte(wc * 32 + fr, fq * 8);
#define PG8_SA(b, h) (((b) * 2 + (h)) * HTB)
#define PG8_SB(b, h) ((4 + (b) * 2 + (h)) * HTB)
#define PG8_STAGE(bufoff, gbase, voff) do { _Pragma("unroll") for (int _i = 0; _i < 2; ++_i) \
        __builtin_amdgcn_global_load_lds((const unsigned*)((const char*)(gbase) + (voff)[_i]), (PG8_LAS unsigned*)(lds + (bufoff) + ldsw + _i * 8192), 16, 0, 0); } while (0)
#define PG8_LDA(dst, b, h) do { _Pragma("unroll") for (int m = 0; m < 4; ++m) _Pragma("unroll") for (int k = 0; k < 2; ++k) dst[m][k] = *(const PG8_LAS bf16x8*)(lds + PG8_SA(b, h) + aoff + m * 2048 + k * 1024); } while (0)
#define PG8_LDB(dst, b, h) do { _Pragma("unroll") for (int n = 0; n < 2; ++n) _Pragma("unroll") for (int k = 0; k < 2; ++k) dst[n][k] = *(const PG8_LAS bf16x8*)(lds + PG8_SB(b, h) + boff + n * 2048 + k * 1024); } while (0)
#define PG8_MMA(ai, bj, At, Bt) do { __builtin_amdgcn_s_setprio(1); _Pragma("unroll") for (int m = 0; m < 4; ++m) _Pragma("unroll") for (int n = 0; n < 2; ++n) _Pragma("unroll") for (int k = 0; k < 2; ++k) \
        acc[ai][bj][m][n] = __builtin_amdgcn_mfma_f32_16x16x32_bf16(Bt[n][k], At[m][k], acc[ai][bj][m][n], 0, 0, 0); __builtin_amdgcn_s_setprio(0); } while (0)
#define PG8_WAIT_V(n) asm volatile("s_waitcnt vmcnt(" #n ")" ::: "memory")
#define PG8_WAIT_L(n) asm volatile("s_waitcnt lgkmcnt(" #n ")" ::: "memory")
#define PG8_BAR __builtin_amdgcn_s_barrier()
#define PG8_SCHED __builtin_amdgcn_sched_barrier(0)
    Unit cur, nxt; int ui = 0;
    if (!S.next(0, cur)) return;
    f32x4 acc[2][2][4][2];
#pragma unroll
    for (int a = 0; a < 2; ++a)
#pragma unroll
        for (int b = 0; b < 2; ++b)
#pragma unroll
            for (int m = 0; m < 4; ++m)
#pragma unroll
                for (int n = 0; n < 2; ++n) acc[a][b][m][n] = (f32x4){0.f, 0.f, 0.f, 0.f};
    bf16x8 At[4][2], B0[2][2], B1[2][2];
    const char* cA = (const char*)g.A + (size_t)cur.pm * tstep; const char* cB = (const char*)g.Bt + (size_t)cur.pn * tstep;
    S.a_ready(cur);
    if constexpr (SP2) {
        PG8_STAGE(PG8_SB(0, 0), cB, voffB); PG8_STAGE(PG8_SB(0, 1), cB + hstep, voffB); PG8_STAGE(PG8_SA(0, 0), cA, voffA); PG8_STAGE(PG8_SA(0, 1), cA + hstep, voffA);
        if (wr == 1) PG8_BAR;
        PG8_WAIT_V(2); PG8_BAR;
        PG8_STAGE(PG8_SB(1, 0), cB + kstep, voffB); PG8_STAGE(PG8_SA(1, 0), cA + kstep, voffA); PG8_STAGE(PG8_SB(1, 1), cB + hstep + kstep, voffB);
        PG8_WAIT_V(6); PG8_BAR;
    } else {
        PG8_STAGE(PG8_SB(0, 0), cB, voffB); PG8_STAGE(PG8_SA(0, 0), cA, voffA); PG8_STAGE(PG8_SB(0, 1), cB + hstep, voffB); PG8_STAGE(PG8_SA(0, 1), cA + hstep, voffA);
        if (wr == 1) PG8_BAR;
        PG8_WAIT_V(4); PG8_BAR;
        PG8_STAGE(PG8_SB(1, 0), cB + kstep, voffB); PG8_STAGE(PG8_SA(1, 0), cA + kstep, voffA); PG8_STAGE(PG8_SB(1, 1), cB + hstep + kstep, voffB);
        PG8_WAIT_V(6); PG8_BAR;
    }
    for (;;) {
        const bool has_next = S.next(ui + 1, nxt);
        const char* nA = has_next ? (const char*)g.A + (size_t)nxt.pm * tstep : cA; const char* nB = has_next ? (const char*)g.Bt + (size_t)nxt.pn * tstep : cB;
        for (int t = 0; t < nt; t += 2) {
            const bool last = (t == nt - 2);
            const char* a1 = cA + (size_t)(t + 1) * kstep;
            const char* a2 = last ? nA : cA + (size_t)(t + 2) * kstep; const char* b2 = last ? nB : cB + (size_t)(t + 2) * kstep;
            const char* a3 = a2 + kstep; const char* b3 = b2 + kstep;
            if (last && has_next) S.a_ready(nxt);
            if constexpr (SP2) {
            PG8_LDB(B0, 0, 0); PG8_LDB(B1, 0, 1); PG8_SCHED; PG8_LDA(At, 0, 0); PG8_STAGE(PG8_SA(1, 1), a1 + hstep, voffA);
            PG8_WAIT_V(8); PG8_WAIT_L(0); PG8_BAR; PG8_MMA(0, 0, At, B0); PG8_MMA(0, 1, At, B1); PG8_BAR; PG8_SCHED;
            PG8_LDA(At, 0, 1); PG8_STAGE(PG8_SB(0, 0), b2, voffB); PG8_STAGE(PG8_SB(0, 1), b2 + hstep, voffB); PG8_STAGE(PG8_SA(0, 0), a2, voffA);
            PG8_WAIT_V(8); PG8_WAIT_L(0); PG8_BAR; PG8_MMA(1, 0, At, B0); PG8_MMA(1, 1, At, B1); PG8_BAR; PG8_SCHED;
            PG8_LDB(B0, 1, 0); PG8_LDB(B1, 1, 1); PG8_SCHED; PG8_LDA(At, 1, 0); PG8_STAGE(PG8_SA(0, 1), a2 + hstep, voffA);
            PG8_WAIT_V(8); PG8_WAIT_L(0); PG8_BAR; PG8_MMA(0, 0, At, B0); PG8_MMA(0, 1, At, B1); PG8_BAR; PG8_SCHED;
            PG8_LDA(At, 1, 1); PG8_STAGE(PG8_SB(1, 0), b3, voffB); PG8_STAGE(PG8_SB(1, 1), b3 + hstep, voffB); PG8_STAGE(PG8_SA(1, 0), a3, voffA);
            PG8_WAIT_V(8); PG8_WAIT_L(0); PG8_BAR; PG8_MMA(1, 0, At, B0); PG8_MMA(1, 1, At, B1); PG8_BAR; PG8_SCHED;
            } else {
            PG8_LDB(B0, 0, 0); PG8_SCHED; PG8_LDA(At, 0, 0); PG8_STAGE(PG8_SA(1, 1), a1 + hstep, voffA);
            PG8_WAIT_L(8); PG8_BAR; PG8_WAIT_L(0); PG8_MMA(0, 0, At, B0); PG8_BAR; PG8_SCHED;
            PG8_LDB(B1, 0, 1); PG8_STAGE(PG8_SB(0, 0), b2, voffB);
            PG8_BAR; PG8_WAIT_L(0); PG8_MMA(0, 1, At, B1); PG8_BAR;
            PG8_LDA(At, 0, 1); PG8_STAGE(PG8_SA(0, 0), a2, voffA);
            PG8_BAR; PG8_WAIT_L(0); PG8_MMA(1, 0, At, B0); PG8_BAR; PG8_SCHED;
            PG8_STAGE(PG8_SB(0, 1), b2 + hstep, voffB);
            PG8_WAIT_V(6); PG8_BAR; PG8_MMA(1, 1, At, B1); PG8_BAR;
            PG8_LDB(B0, 1, 0); PG8_SCHED; PG8_LDA(At, 1, 0); PG8_STAGE(PG8_SA(0, 1), a2 + hstep, voffA);
            PG8_WAIT_L(8); PG8_BAR; PG8_WAIT_L(0); PG8_MMA(0, 0, At, B0); PG8_BAR; PG8_SCHED;
            PG8_LDB(B1, 1, 1); PG8_STAGE(PG8_SB(1, 0), b3, voffB);
            PG8_BAR; PG8_WAIT_L(0); PG8_MMA(0, 1, At, B1); PG8_BAR;
            PG8_LDA(At, 1, 1); PG8_STAGE(PG8_SA(1, 0), a3, voffA);
            PG8_BAR; PG8_WAIT_L(0); PG8_MMA(1, 0, At, B0); PG8_BAR; PG8_SCHED;
            PG8_STAGE(PG8_SB(1, 1), b3 + hstep, voffB);
            PG8_WAIT_V(6); PG8_BAR; PG8_MMA(1, 1, At, B1); PG8_BAR;
            }
        }
        if constexpr (ALIGN_EPI) { if (wr == 0) PG8_BAR; }
        if constexpr (!Epi::AFTER_DRAIN) { E(acc, cur, wr, wc, fr, fq); S.done(cur); }
        if (!has_next) break;
#pragma unroll
        for (int a = 0; a < 2; ++a)
#pragma unroll
            for (int b = 0; b < 2; ++b)
#pragma unroll
                for (int m = 0; m < 4; ++m)
#pragma unroll
                    for (int n = 0; n < 2; ++n) acc[a][b][m][n] = (f32x4){0.f, 0.f, 0.f, 0.f};
        cur = nxt; cA = nA; cB = nB; ++ui;
        if constexpr (ALIGN_EPI) { if (wr == 1) PG8_BAR; }
    }
    PG8_WAIT_V(0);
    if constexpr (!ALIGN_EPI) { if (wr == 0) PG8_BAR; }
    PG8_BAR;
    if constexpr (Epi::AFTER_DRAIN) { E.fused(acc, cur, wr, wc, fr, fq, lds, wid, lane); S.done(cur); }
#undef PG8_SA
#undef PG8_SB
#undef PG8_STAGE
#undef PG8_LDA
#undef PG8_LDB
#undef PG8_MMA
#undef PG8_WAIT_V
#undef PG8_WAIT_L
#undef PG8_BAR
#undef PG8_SCHED
}
}
#define GAS __attribute__((address_space(1)))
#define LAS __attribute__((address_space(3)))
typedef unsigned short bf16;
typedef unsigned v4u __attribute__((ext_vector_type(4)));
typedef float f32x4 __attribute__((ext_vector_type(4)));
typedef short bf16x8 __attribute__((ext_vector_type(8)));
typedef GAS unsigned gu32;
typedef GAS unsigned long long gu64;
#define RLX_AGENT __ATOMIC_RELAXED, __HIP_MEMORY_SCOPE_AGENT
#define LDS_WAIT() asm volatile("s_waitcnt lgkmcnt(0)" ::: "memory")
#define VM_WAIT() asm volatile("s_waitcnt vmcnt(0)" ::: "memory")
__device__ __forceinline__ unsigned long long rt() { return __builtin_amdgcn_s_memrealtime(); }
__device__ __forceinline__ unsigned f2bf(float f) { unsigned u = __builtin_bit_cast(unsigned, f); return (u + 0x7fffu + ((u >> 16) & 1u)) >> 16; }
__device__ __forceinline__ unsigned pk2(float lo, float hi) { return f2bf(lo) | (f2bf(hi) << 16); }

#define XB_TMO      128
#define XB_XCNT(j)  (256  + 64 * (j))
#define XB_XSUB(j)  (1280 + 64 * (j))
#define XB_XGEN(j)  (2304 + 64 * (j))
#define XB_TOP      3328
#define XB_TOPGEN   3392
#define XCD_BAR_WORDS 3456
#define XB_SPIN_CAP (1u << 18)

__device__ __forceinline__ unsigned xb_ld(unsigned* p)              { return __hip_atomic_load(p, __ATOMIC_RELAXED, __HIP_MEMORY_SCOPE_AGENT); }
__device__ __forceinline__ unsigned xb_add(unsigned* p, unsigned v) { return __hip_atomic_fetch_add(p, v, __ATOMIC_RELAXED, __HIP_MEMORY_SCOPE_AGENT); }
__device__ __forceinline__ unsigned xb_xcc_id() { return (unsigned)__builtin_amdgcn_s_getreg((3 << 11) | 20) & 0xFu; }
#define XB_SPIN(cond, bar) do { unsigned _sp = 0; while (cond) { __builtin_amdgcn_s_sleep(1); \
    if ((++_sp & 255u) == 0u) { if (xb_ld(&(bar)[XB_TMO])) break; if (_sp > XB_SPIN_CAP) { atomicAdd(&(bar)[XB_TMO], 1u); break; } } } } while (0)

struct XcdBarrier {
    unsigned* bar; unsigned x;
    volatile LAS unsigned* st;
};

__device__ __forceinline__ XcdBarrier xcd_barrier_post(unsigned* bar, volatile LAS unsigned* st) {
    XcdBarrier b; b.bar = bar; b.x = xb_xcc_id(); b.st = st;
    if (threadIdx.x == 0) (void)xb_add(&bar[XB_XCNT(b.x)], 1u);
    return b;
}
__device__ __forceinline__ void xcd_barrier_complete(unsigned* bar, unsigned x, unsigned& nloc, unsigned& nx) {
    const unsigned G = gridDim.x * gridDim.y * gridDim.z;
    unsigned sum, cnt, mine, sp = 0u;
    for (;;) {
        sum = 0u; cnt = 0u; mine = 0u;
#pragma unroll
        for (unsigned j = 0; j < 16; ++j) { const unsigned c = xb_ld(&bar[XB_XCNT(j)]); sum += c; cnt += (c > 0u) ? 1u : 0u; mine = (j == x) ? c : mine; }
        if (sum == G) break;
        __builtin_amdgcn_s_sleep(1);
        if ((++sp & 255u) == 0u) { if (xb_ld(&bar[XB_TMO])) break; if (sp > XB_SPIN_CAP) { atomicAdd(&bar[XB_TMO], 1u); break; } }
    }
    nloc = mine > 0u ? mine : 1u; nx = cnt > 0u ? cnt : 1u;
}

__device__ __forceinline__ void xcd_barrier(const XcdBarrier& b) {
    asm volatile("s_waitcnt vmcnt(0)" ::: "memory");
    __syncthreads();
    if (threadIdx.x == 0) {
        unsigned* bar = b.bar;
        __builtin_amdgcn_s_waitcnt(0);
        unsigned nloc = b.st[0], nx = b.st[1];
        if (nloc == 0u) { xcd_barrier_complete(bar, b.x, nloc, nx); b.st[0] = nloc; b.st[1] = nx; }
        const unsigned old = xb_add(&bar[XB_XSUB(b.x)], 1u);
        const unsigned gen = old / nloc;
        if (old + 1u == (gen + 1u) * nloc) {
            __builtin_amdgcn_fence(__ATOMIC_RELEASE, "agent");
            asm volatile("s_waitcnt vmcnt(0)" ::: "memory");
            const unsigned og = xb_add(&bar[XB_TOP], 1u);
            const unsigned tg = og / nx;
            if (og + 1u == (tg + 1u) * nx) xb_add(&bar[XB_TOPGEN], 1u);
            else XB_SPIN(xb_ld(&bar[XB_TOPGEN]) == tg, bar);
            __builtin_amdgcn_fence(__ATOMIC_ACQUIRE, "agent");
            xb_add(&bar[XB_XGEN(b.x)], 1u);
            asm volatile("s_waitcnt vmcnt(0)" ::: "memory");
        } else {
            XB_SPIN(xb_ld(&bar[XB_XGEN(b.x)]) == gen, bar);
            __builtin_amdgcn_fence(__ATOMIC_ACQUIRE, "agent");
            asm volatile("s_waitcnt vmcnt(0)" ::: "memory");
        }
    }
    __syncthreads();
}

constexpr int M = 16384, D = 1024, BR = 2048, GWID = 2304, QMW = 256;
constexpr float EPS = 1e-6f, LOG2E = 1.4426950408889634f, C2 = 0.125f * 1.4426950408889634f, NEGBIG = -1e30f;
constexpr float LAM_INIT = 0.35550907f;
typedef float f32x16 __attribute__((ext_vector_type(16)));
typedef unsigned u32x2 __attribute__((ext_vector_type(2)));
typedef int i32x4 __attribute__((ext_vector_type(4)));
typedef short s16x4 __attribute__((ext_vector_type(4)));

constexpr size_t MiB = 1u << 20, KiB = 1024;
constexpr size_t WS_BAR = 0;
constexpr size_t WS_RSTD = 64 * KiB, WS_SS = 128 * KiB, WS_KMEM = 192 * KiB, WS_VMEMT = 320 * KiB, WS_MEMN = 448 * KiB, WS_MISC = 960 * KiB;
constexpr size_t WS_WMEM = 1 * MiB, WS_WIN = 2 * MiB, WS_WOUT = 19 * MiB, WS_XB = 24 * MiB, WS_QM = 56 * MiB;
constexpr size_t WS_RQ = 64 * MiB, WS_RK = 128 * MiB, WS_RV = 192 * MiB, WS_END = 256 * MiB;
constexpr size_t WS_SGY = 128 * MiB;
constexpr size_t WS_KS = 200 * MiB, WS_VTS = 208 * MiB;
constexpr int LDS_BYTES = 147456, MISC_OFF = LDS_BYTES - 128;
constexpr int NWAVES = 8;

__device__ __forceinline__ float silu_f(float x) { return x * __builtin_amdgcn_rcpf(1.0f + __builtin_amdgcn_exp2f(-x * LOG2E)); }
__device__ __forceinline__ unsigned pkbf(float lo, float hi) { return pg8::cvt_pk_bf16(lo, hi); }
__device__ __forceinline__ float bf_lo(unsigned u) { return __uint_as_float(u << 16); }
__device__ __forceinline__ float bf_hi(unsigned u) { return __uint_as_float(u & 0xffff0000u); }

enum { EM_CONV = 0, EM_DIFF1, EM_VT, EM_GATE, EM_SWA, EM_PLAIN, EM_OUT };
struct Epi {
    static constexpr bool PERM = true, AFTER_DRAIN = false;
    int mode; int ldc; const float* rstd; unsigned char* ws; bf16* o0; float* ss;
    __device__ __forceinline__ void operator()(const pg8::f32x4 (&acc)[2][2][4][2], const pg8::Unit& u, int wr, int wc, int fr, int fq) const {
        using pg8::f32x4; typedef unsigned u32x4v __attribute__((ext_vector_type(4)));
        const int row0 = u.pm * 256 + wr * 64 + fr, tc8 = wc * 32 + fq * 8;
        bf16* RQ = (bf16*)(ws + WS_RQ); bf16* RK = (bf16*)(ws + WS_RK); bf16* QM = (bf16*)(ws + WS_QM); bf16* SGY = (bf16*)(ws + WS_SGY); bf16* KS = (bf16*)(ws + WS_KS);
#define ST8(ptr, a, b) do { u32x4v w_; w_.x = pkbf((a)[0], (a)[1]); w_.y = pkbf((a)[2], (a)[3]); w_.z = pkbf((b)[0], (b)[1]); w_.w = pkbf((b)[2], (b)[3]); *(u32x4v*)(ptr) = w_; } while (0)
        if (mode == EM_CONV) {
            if (u.pn < 32) {
                const int col = u.pn * 64 + wc * 16 + fq * 4;
#pragma unroll
                for (int ai = 0; ai < 2; ++ai)
#pragma unroll
                    for (int m = 0; m < 4; ++m) { const int row = row0 + ai * 128 + m * 16; const float rs = rstd[row];
                        const f32x4 bg = acc[ai][0][m][0] * rs, cgv = acc[ai][0][m][1] * rs, uu = acc[ai][1][m][0] * rs, gt = acc[ai][1][m][1] * rs;
                        const f32x4 z = cgv * uu; f32x4 b; b[0] = bg[0] * silu_f(gt[0]); b[1] = bg[1] * silu_f(gt[1]); b[2] = bg[2] * silu_f(gt[2]); b[3] = bg[3] * silu_f(gt[3]);
                        u32x2 zz; zz.x = pkbf(z[0], z[1]); zz.y = pkbf(z[2], z[3]); *(u32x2*)(RQ + (size_t)row * BR + col) = zz;
                        u32x2 bb; bb.x = pkbf(b[0], b[1]); bb.y = pkbf(b[2], b[3]); *(u32x2*)(SGY + (size_t)row * GWID + col) = bb; }
            } else {
                const int col = (u.pn - 32) * 128 + tc8;
#pragma unroll
                for (int ai = 0; ai < 2; ++ai)
#pragma unroll
                    for (int m = 0; m < 4; ++m) { const int row = row0 + ai * 128 + m * 16; const float rs = rstd[row]; const float rq = rs * C2;
                        const f32x4 q0 = acc[ai][0][m][0] * rq, q1 = acc[ai][0][m][1] * rq; ST8(QM + (size_t)row * QMW + col, q0, q1);
                        f32x4 g0 = acc[ai][1][m][0] * rs, g1 = acc[ai][1][m][1] * rs;
#pragma unroll
                        for (int j = 0; j < 4; ++j) { g0[j] = silu_f(g0[j]); g1[j] = silu_f(g1[j]); }
                        ST8(SGY + (size_t)row * GWID + BR + col, g0, g1); }
            }
        } else if (mode == EM_DIFF1 || mode == EM_SWA) {
            bf16* dst; int pitch; float sc = 1.f; int act = 0; const int pn = u.pn;
            if (pn < 8) { dst = RQ + pn * 256; pitch = BR; sc = C2; }
            else if (mode == EM_DIFF1) { if (pn < 16) { dst = RK + (pn - 8) * 256; pitch = BR; } else { dst = QM; pitch = QMW; sc = C2; } }
            else { if (pn == 8) { dst = KS; pitch = 256; } else if (pn == 9) { dst = QM; pitch = QMW; sc = C2; } else { dst = SGY + (pn - 10) * 256; pitch = GWID; act = 1; } }
#pragma unroll
            for (int ai = 0; ai < 2; ++ai)
#pragma unroll
                for (int m = 0; m < 4; ++m) { const int row = row0 + ai * 128 + m * 16; const float rs = rstd[row] * sc;
#pragma unroll
                    for (int bj = 0; bj < 2; ++bj) { f32x4 v0 = acc[ai][bj][m][0] * rs, v1 = acc[ai][bj][m][1] * rs;
                        if (act) {
#pragma unroll
                            for (int j = 0; j < 4; ++j) { v0[j] = silu_f(v0[j]); v1[j] = silu_f(v1[j]); } }
                        ST8(dst + (size_t)row * pitch + bj * 128 + tc8, v0, v1); } }
            if (mode == EM_DIFF1 && pn >= 8 && pn < 16) {
                unsigned* KN2 = (unsigned*)(ws + WS_MISC);
                asm volatile("" ::: "memory");
#pragma unroll
                for (int bj = 0; bj < 2; ++bj) { float q = 0.f;
#pragma unroll
                    for (int ai = 0; ai < 2; ++ai)
#pragma unroll
                        for (int m = 0; m < 4; ++m) { const float rs = rstd[row0 + ai * 128 + m * 16]; const f32x4 v0 = acc[ai][bj][m][0] * rs, v1 = acc[ai][bj][m][1] * rs;
                            q = fmaxf(q, (v0[0] * v0[0] + v0[1] * v0[1]) + (v0[2] * v0[2] + v0[3] * v0[3]) + (v1[0] * v1[0] + v1[1] * v1[1]) + (v1[2] * v1[2] + v1[3] * v1[3])); }
                    q += __shfl_xor(q, 16); q += __shfl_xor(q, 32);
                    q = fmaxf(q, __shfl_xor(q, 1)); q = fmaxf(q, __shfl_xor(q, 2)); q = fmaxf(q, __shfl_xor(q, 4)); q = fmaxf(q, __shfl_xor(q, 8));
                    if (fr == 0 && fq == 0) atomicMax(KN2 + ((pn - 8) * 4 + 2 * bj + (wc >> 1)) * 2 + (wc & 1), __float_as_uint(q)); }
            }
        } else if (mode == EM_VT) {
#pragma unroll
            for (int bj = 0; bj < 2; ++bj) { const int col = u.pn * 256 + bj * 128 + tc8; f32x4 r0 = {1.f, 1.f, 1.f, 1.f}, r1 = r0;
                if (rstd) { r0 = *(const f32x4*)(rstd + col); r1 = *(const f32x4*)(rstd + col + 4); }
                const int p0 = col - (fq & 1) * 8 + (fq & 1) * 4;
#pragma unroll
                for (int ai = 0; ai < 2; ++ai)
#pragma unroll
                    for (int m = 0; m < 4; ++m) { const int row = row0 + ai * 128 + m * 16; const f32x4 v0 = acc[ai][bj][m][0] * r0, v1 = acc[ai][bj][m][1] * r1;
                        u32x2 a_, b_; a_.x = pkbf(v0[0], v0[1]); a_.y = pkbf(v0[2], v0[3]); b_.x = pkbf(v1[0], v1[1]); b_.y = pkbf(v1[2], v1[3]);
                        *(u32x2*)(o0 + (size_t)row * ldc + p0) = a_; *(u32x2*)(o0 + (size_t)row * ldc + p0 + 8) = b_; } }
        } else if (mode == EM_GATE) {
            const int pn = u.pn; const bf16* src; int sp; if (pn < 8) { src = RQ + pn * 256; sp = BR; } else { src = QM; sp = QMW; }
            bf16* dst = SGY + pn * 256;
#pragma unroll
            for (int ai = 0; ai < 2; ++ai)
#pragma unroll
                for (int m = 0; m < 4; ++m) { const int row = row0 + ai * 128 + m * 16; const float rs = rstd[row];
#pragma unroll
                    for (int bj = 0; bj < 2; ++bj) { f32x4 v0 = acc[ai][bj][m][0] * rs, v1 = acc[ai][bj][m][1] * rs;
                        const u32x4v mx = *(const u32x4v*)(src + (size_t)row * sp + bj * 128 + tc8);
                        v0[0] = silu_f(v0[0]) * bf_lo(mx.x); v0[1] = silu_f(v0[1]) * bf_hi(mx.x); v0[2] = silu_f(v0[2]) * bf_lo(mx.y); v0[3] = silu_f(v0[3]) * bf_hi(mx.y);
                        v1[0] = silu_f(v1[0]) * bf_lo(mx.z); v1[1] = silu_f(v1[1]) * bf_hi(mx.z); v1[2] = silu_f(v1[2]) * bf_lo(mx.w); v1[3] = silu_f(v1[3]) * bf_hi(mx.w);
                        ST8(dst + (size_t)row * GWID + bj * 128 + tc8, v0, v1); } }
        } else if (mode == EM_PLAIN) {
#pragma unroll
            for (int ai = 0; ai < 2; ++ai)
#pragma unroll
                for (int m = 0; m < 4; ++m) { const int row = row0 + ai * 128 + m * 16;
#pragma unroll
                    for (int bj = 0; bj < 2; ++bj) ST8(o0 + (size_t)row * ldc + u.pn * 256 + bj * 128 + tc8, acc[ai][bj][m][0], acc[ai][bj][m][1]); }
        } else {
            float* YO = (float*)(ws + WS_RQ);
#pragma unroll
            for (int ai = 0; ai < 2; ++ai)
#pragma unroll
                for (int m = 0; m < 4; ++m) { const int row = row0 + ai * 128 + m * 16; float q = 0.f;
#pragma unroll
                    for (int bj = 0; bj < 2; ++bj) { const f32x4 v0 = acc[ai][bj][m][0], v1 = acc[ai][bj][m][1];
                        float* p = YO + (size_t)row * D + u.pn * 256 + bj * 128 + tc8; *(f32x4*)p = v0; *(f32x4*)(p + 4) = v1;
                        q += (v0[0] * v0[0] + v0[1] * v0[1]) + (v0[2] * v0[2] + v0[3] * v0[3]) + (v1[0] * v1[0] + v1[1] * v1[1]) + (v1[2] * v1[2] + v1[3] * v1[3]); }
                    q += __shfl_xor(q, 16); q += __shfl_xor(q, 32);
                    if (fq == 0) ss[(size_t)row * 16 + u.pn * 4 + wc] = q; }
        }
#undef ST8
    }
};
struct OneUnit { int has;
    __device__ __forceinline__ bool next(int i, pg8::Unit& u) const { if (i > 0 || !has) return false; u.pm = 0; u.pn = 0; return true; }
    __device__ __forceinline__ void a_ready(const pg8::Unit&) const {}
    __device__ __forceinline__ void done(const pg8::Unit&) const {} };

struct Args { const void* in[35]; float* out; unsigned char* ws; int ph_lo, ph_hi; };
struct Frame { LAS unsigned char* lds; int tid, lane, wave, G, bx, gw, NGW; unsigned char* ws; };
__device__ __forceinline__ void frame_refresh(Frame& F) { int t = threadIdx.x; asm volatile("" : "+v"(t)); F.tid = t; F.lane = t & 63; F.wave = __builtin_amdgcn_readfirstlane(t >> 6); F.gw = F.bx * NWAVES + F.wave; }

__device__ __forceinline__ float wave_sum(float v) {
#pragma unroll
    for (int o = 1; o < 64; o <<= 1) v += __shfl_xor(v, o);
    return v;
}
__device__ __forceinline__ int win_srccol(int kind, int n) {
    if (kind == 0) {
        const int pn = n >> 8, tc = n & 255;
        if (pn < 32) { const int bj = tc >> 7, wc = (tc >> 5) & 3, i = tc & 31, fq = i >> 3, nn = (i >> 2) & 1, j = i & 3, s = 2 * bj + nn;
            const int base = (s == 0) ? 0 : (s == 1) ? 2048 : (s == 2) ? 4096 : 6400; return base + pn * 64 + wc * 16 + fq * 4 + j; }
        const int t = pn - 32, bj = tc >> 7, c = tc & 127; return (bj == 0 ? 6144 : 6400 + 2048) + t * 128 + c;
    } else if (kind == 1) {
        if (n < 4096) return n; if (n < 4352) return 6144 + (n - 4096); if (n < 6400) return 4096 + (n - 4352); return n;
    } else {
        if (n < 2304) return n; if (n < 2560) return 2560 + (n - 2304); if (n < 4864) return 2816 + (n - 2560); return 2304 + (n - 4864);
    }
}
__device__ __forceinline__ void transpose_item(const float* W, int K, int Nsrc, const float* gain, int mapmode, bf16* WT, LAS float* scr, int item, int nblk, int lane) {
    const int kb = item / nblk, nb = item % nblk, k0 = 64 * kb, n0 = 32 * nb;
    const int nd = n0 + (lane & 31); const int sc = (mapmode < 0) ? nd : win_srccol(mapmode, nd);
#pragma unroll 8
    for (int i = 0; i < 32; ++i) { const int kk = 2 * i + (lane >> 5); float v = W[(size_t)(k0 + kk) * Nsrc + sc]; if (gain) v *= gain[k0 + kk]; scr[kk * 33 + (lane & 31)] = v; }
    LDS_WAIT(); asm volatile("" ::: "memory");
    const int c = lane & 7;
#pragma unroll
    for (int j = 0; j < 4; ++j) { const int n = (lane >> 3) + 8 * j; const LAS float* s = scr + (8 * c) * 33 + n;
        v4u o; o.x = pk2(s[0 * 33], s[1 * 33]); o.y = pk2(s[2 * 33], s[3 * 33]); o.z = pk2(s[4 * 33], s[5 * 33]); o.w = pk2(s[6 * 33], s[7 * 33]);
        *(GAS v4u*)(WT + (size_t)(n0 + n) * K + k0 + 8 * c) = o; }
    LDS_WAIT(); asm volatile("" ::: "memory");
}

__device__ __forceinline__ void prep_phase(Frame& F, const Args& a, int L) {
    float* rstd = (float*)(F.ws + WS_RSTD); float* ss = (float*)(F.ws + WS_QM); bf16* XB = (bf16*)(F.ws + WS_XB); const float* YO = (const float*)(F.ws + WS_RQ);
    const int base_prev = (L == 1) ? 3 : (L == 2) ? 10 : (L == 3) ? 21 : 28;
    const float* gpost = (L > 0) ? (const float*)a.in[base_prev + 1] : nullptr;
    const float* xin = (L <= 1) ? (const float*)a.in[0] : a.out;
    for (int m = F.gw; m < M; m += F.NGW) {
        const GAS f32x4* xr = (const GAS f32x4*)(xin + (size_t)m * D) + F.lane;
        f32x4 v[4];
#pragma unroll
        for (int j = 0; j < 4; ++j) v[j] = xr[64 * j];
        if (L > 0) {
            float ssum = 0.f; { const f32x4* sp = (const f32x4*)(ss + (size_t)m * 16); const f32x4 a0 = sp[0], a1 = sp[1], a2 = sp[2], a3 = sp[3];
                ssum = ((a0.x + a0.y) + (a0.z + a0.w)) + ((a1.x + a1.y) + (a1.z + a1.w)) + ((a2.x + a2.y) + (a2.z + a2.w)) + ((a3.x + a3.y) + (a3.z + a3.w)); }
            const float r = 1.0f / sqrtf(ssum * (1.0f / D) + EPS);
            const GAS f32x4* yr = (const GAS f32x4*)(YO + (size_t)m * D) + F.lane; const GAS f32x4* gp = (const GAS f32x4*)gpost + F.lane;
#pragma unroll
            for (int j = 0; j < 4; ++j) { const f32x4 y = yr[64 * j], g = gp[64 * j]; v[j] = v[j] + y * g * r; }
            GAS f32x4* xo = (GAS f32x4*)(a.out + (size_t)m * D) + F.lane;
#pragma unroll
            for (int j = 0; j < 4; ++j) xo[64 * j] = v[j];
        }
        if (L < 4) {
            float s2 = 0.f;
#pragma unroll
            for (int j = 0; j < 4; ++j) s2 += (v[j].x * v[j].x + v[j].y * v[j].y) + (v[j].z * v[j].z + v[j].w * v[j].w);
            s2 = wave_sum(s2);
            GAS unsigned long long* o8 = (GAS unsigned long long*)(XB + (size_t)m * D) + F.lane;
#pragma unroll
            for (int j = 0; j < 4; ++j) o8[64 * j] = (unsigned long long)pk2(v[j].x, v[j].y) | ((unsigned long long)pk2(v[j].z, v[j].w) << 32);
            if (F.lane == 0) rstd[m] = 1.0f / sqrtf(s2 * (1.0f / D) + EPS);
        }
    }
    if (L >= 4) return;
    if (L == 1 && F.bx == 0) {
        unsigned* KN2 = (unsigned*)(F.ws + WS_MISC); int* PM = (int*)(F.ws + WS_MISC + 1024); const int* pos = (const int*)a.in[2];
        if (F.tid < 64) KN2[F.tid] = 0u;
        LAS int* bm = (LAS int*)(F.lds + 8 * 16384);
        if (F.tid < 256) { int mxp = pos[F.tid * 64]; for (int j = 1; j < 64; ++j) mxp = max(mxp, pos[F.tid * 64 + j]); bm[F.tid] = mxp; }
        __syncthreads();
        if (F.tid < 256) { int mxp = bm[0]; for (int j = 1; j <= F.tid; ++j) mxp = max(mxp, bm[j]); PM[F.tid] = mxp; }
        __syncthreads();
    }
    const int base = (L == 0) ? 3 : (L == 1) ? 10 : (L == 2) ? 21 : 28; const int kind = (L == 3) ? 0 : L;
    const float* gpre = (const float*)a.in[base]; const float* gmem = (const float*)a.in[base + 2];
    const float* w_in = (const float*)a.in[base + 3]; const float* w_mem = (const float*)a.in[base + 4];
    const float* w_out = (const float*)a.in[(L == 0) ? 9 : (L == 1) ? 20 : (L == 2) ? 27 : 34];
    const int NIN = (kind == 2) ? 5120 : 8704;
    bf16* MEMN = (bf16*)(F.ws + WS_MEMN);
    for (int m = F.gw; m < 256; m += F.NGW) {
        const GAS f32x4* xr = (const GAS f32x4*)((const float*)a.in[1] + (size_t)m * D) + F.lane; const GAS f32x4* gp = (const GAS f32x4*)gmem + F.lane;
        f32x4 v[4]; float s2 = 0.f;
#pragma unroll
        for (int j = 0; j < 4; ++j) { v[j] = xr[64 * j]; s2 += (v[j].x * v[j].x + v[j].y * v[j].y) + (v[j].z * v[j].z + v[j].w * v[j].w); }
        const float r = 1.0f / sqrtf(wave_sum(s2) * (1.0f / D) + EPS);
        GAS unsigned long long* o8 = (GAS unsigned long long*)(MEMN + (size_t)m * D) + F.lane;
#pragma unroll
        for (int j = 0; j < 4; ++j) { const f32x4 g = gp[64 * j]; const f32x4 t = v[j] * g * r; o8[64 * j] = (unsigned long long)pk2(t.x, t.y) | ((unsigned long long)pk2(t.z, t.w) << 32); }
    }
    LAS float* scr = (LAS float*)(F.lds + F.wave * 16384);
    const int I_IN = (D / 64) * (NIN / 32), I_OUT = (GWID / 64) * (D / 32), I_MEM = (D / 64) * (512 / 32);
    for (int it = F.gw; it < I_IN + I_OUT + I_MEM; it += F.NGW) {
        int r = it;
        if (r < I_IN) { transpose_item(w_in, D, NIN, gpre, kind, (bf16*)(F.ws + WS_WIN), scr, r, NIN / 32, F.lane); continue; } r -= I_IN;
        if (r < I_OUT) { transpose_item(w_out, GWID, D, nullptr, -1, (bf16*)(F.ws + WS_WOUT), scr, r, D / 32, F.lane); continue; } r -= I_OUT;
        transpose_item(w_mem, D, 512, nullptr, -1, (bf16*)(F.ws + WS_WMEM), scr, r, 512 / 32, F.lane);
    }
}

__device__ __forceinline__ void conv_phase(Frame& F, const float* convw) {
    const bf16* Z = (const bf16*)(F.ws + WS_RQ); bf16* SGY = (bf16*)(F.ws + WS_SGY);
    const int nthreads = F.G * 512; const int gt = F.bx * 512 + F.tid;
    for (int task = gt; task < 256 * 512; task += nthreads) {
        const int cc = (task & 255) * 8, t0 = (task >> 8) * 32;
        float w0[8], w1[8], w2[8];
#pragma unroll
        for (int j = 0; j < 8; ++j) { w0[j] = convw[cc + j]; w1[j] = convw[BR + cc + j]; w2[j] = convw[2 * BR + cc + j]; }
        float za[8], zb[8];
        if (t0 >= 2) { const v4u a = *(const v4u*)(Z + (size_t)(t0 - 2) * BR + cc), b = *(const v4u*)(Z + (size_t)(t0 - 1) * BR + cc);
            za[0] = bf_lo(a.x); za[1] = bf_hi(a.x); za[2] = bf_lo(a.y); za[3] = bf_hi(a.y); za[4] = bf_lo(a.z); za[5] = bf_hi(a.z); za[6] = bf_lo(a.w); za[7] = bf_hi(a.w);
            zb[0] = bf_lo(b.x); zb[1] = bf_hi(b.x); zb[2] = bf_lo(b.y); zb[3] = bf_hi(b.y); zb[4] = bf_lo(b.z); zb[5] = bf_hi(b.z); zb[6] = bf_lo(b.w); zb[7] = bf_hi(b.w);
        } else {
#pragma unroll
            for (int j = 0; j < 8; ++j) { za[j] = 0.f; zb[j] = 0.f; } }
#pragma unroll 4
        for (int t = t0; t < t0 + 32; ++t) {
            const v4u c = *(const v4u*)(Z + (size_t)t * BR + cc); const v4u g = *(const v4u*)(SGY + (size_t)t * GWID + cc);
            float zc[8], gg[8];
            zc[0] = bf_lo(c.x); zc[1] = bf_hi(c.x); zc[2] = bf_lo(c.y); zc[3] = bf_hi(c.y); zc[4] = bf_lo(c.z); zc[5] = bf_hi(c.z); zc[6] = bf_lo(c.w); zc[7] = bf_hi(c.w);
            gg[0] = bf_lo(g.x); gg[1] = bf_hi(g.x); gg[2] = bf_lo(g.y); gg[3] = bf_hi(g.y); gg[4] = bf_lo(g.z); gg[5] = bf_hi(g.z); gg[6] = bf_lo(g.w); gg[7] = bf_hi(g.w);
            float o[8];
#pragma unroll
            for (int j = 0; j < 8; ++j) { o[j] = gg[j] * (w0[j] * za[j] + w1[j] * zb[j] + w2[j] * zc[j]); za[j] = zb[j]; zb[j] = zc[j]; }
            v4u w; w.x = pkbf(o[0], o[1]); w.y = pkbf(o[2], o[3]); w.z = pkbf(o[4], o[5]); w.w = pkbf(o[6], o[7]);
            *(v4u*)(SGY + (size_t)t * GWID + cc) = w;
        }
    }
}

template <int MODE, bool OUTMUL>
__device__ __forceinline__ void attn256_task(const bf16* Qp, int qpitch, const bf16* Kp, int kpitch, int krow0, const bf16* Vtp, int vpitch, bf16* Op, int opitch,
                                             const int* pos, int prow0, float sl2, float sink2, int lane) {
    const int r32 = lane & 31, hi = lane >> 5;
    bf16x8 qf[4];
#pragma unroll
    for (int d0 = 0; d0 < 4; ++d0) qf[d0] = *(const bf16x8*)(Qp + (size_t)r32 * qpitch + d0 * 16 + hi * 8);
    float mrun = (MODE == 1) ? sink2 : NEGBIG, den = 0.f; int pq = 0; if (MODE == 1) pq = pos[prow0 + r32];
    f32x16 o[2]; o[0] = (f32x16){}; o[1] = (f32x16){};
#pragma unroll
    for (int hb = 0; hb < 2; ++hb) {
        f32x16 s[4];
#pragma unroll
        for (int kq = 0; kq < 4; ++kq) { const int kb = 4 * hb + kq;
            int kr = krow0 + 32 * kb + r32; if (MODE == 1 && kr < 0) kr = 0;
            const bf16* kp = Kp + (size_t)kr * kpitch + hi * 8;
            f32x16 accv = {};
#pragma unroll
            for (int d0 = 0; d0 < 4; ++d0) { const bf16x8 kf = *(const bf16x8*)(kp + d0 * 16); accv = __builtin_amdgcn_mfma_f32_32x32x16_bf16(kf, qf[d0], accv, 0, 0, 0); }
            s[kq] = accv; __builtin_amdgcn_sched_barrier(0);
        }
        float mx = NEGBIG;
        if (MODE == 1) {
#pragma unroll
            for (int kq = 0; kq < 4; ++kq)
#pragma unroll
                for (int g = 0; g < 4; ++g) { const int sidx = 32 * (4 * hb + kq) + 8 * g + 4 * hi; int kr = krow0 + sidx; const bool kvalid = kr >= 0; if (kr < 0) kr = 0;
                    const i32x4 pk = *(const i32x4*)(pos + kr);
#pragma unroll
                    for (int j = 0; j < 4; ++j) { const int rel = pq - pk[j]; const bool ok = kvalid && rel >= 0 && rel < 128;
                        const float v = ok ? (s[kq][4 * g + j] - sl2 * (float)rel) : NEGBIG; s[kq][4 * g + j] = v; mx = fmaxf(mx, v); } }
        } else {
#pragma unroll
            for (int kq = 0; kq < 4; ++kq)
#pragma unroll
                for (int r = 0; r < 16; ++r) mx = fmaxf(mx, s[kq][r]);
        }
        mx = fmaxf(mx, __shfl_xor(mx, 32));
        const float mnew = fmaxf(mrun, mx), al = __builtin_amdgcn_exp2f(mrun - mnew); mrun = mnew; den *= al; o[0] *= al; o[1] *= al;
#pragma unroll
        for (int kq = 0; kq < 4; ++kq)
#pragma unroll
            for (int r = 0; r < 16; ++r) { const float p = __builtin_amdgcn_exp2f(s[kq][r] - mnew); s[kq][r] = p; den += p; }
        __builtin_amdgcn_sched_barrier(0);
#pragma unroll
        for (int kq = 0; kq < 4; ++kq)
#pragma unroll
            for (int sh = 0; sh < 2; ++sh) { const int kb = 4 * hb + kq;
                v4u pw; pw.x = pkbf(s[kq][8 * sh + 0], s[kq][8 * sh + 1]); pw.y = pkbf(s[kq][8 * sh + 2], s[kq][8 * sh + 3]); pw.z = pkbf(s[kq][8 * sh + 4], s[kq][8 * sh + 5]); pw.w = pkbf(s[kq][8 * sh + 6], s[kq][8 * sh + 7]);
                const bf16x8 pb = __builtin_bit_cast(bf16x8, pw);
                int vc = krow0 + 32 * kb + 16 * sh + 8 * hi; if (MODE == 1 && vc < 0) vc = 0;
#pragma unroll
                for (int eb = 0; eb < 2; ++eb) { const bf16x8 av = *(const bf16x8*)(Vtp + (size_t)(32 * eb + r32) * vpitch + vc);
                    o[eb] = __builtin_amdgcn_mfma_f32_32x32x16_bf16(av, pb, o[eb], 0, 0, 0); }
                __builtin_amdgcn_sched_barrier(0);
            }
    }
    den += __shfl_xor(den, 32);
    if (MODE == 1) den += __builtin_amdgcn_exp2f(sink2 - mrun);
    const float inv = 1.0f / den;
#pragma unroll
    for (int eb = 0; eb < 2; ++eb)
#pragma unroll
        for (int g = 0; g < 4; ++g) { bf16* op = Op + (size_t)r32 * opitch + 32 * eb + 8 * g + 4 * hi;
            float v0 = o[eb][4 * g] * inv, v1 = o[eb][4 * g + 1] * inv, v2 = o[eb][4 * g + 2] * inv, v3 = o[eb][4 * g + 3] * inv;
            if (OUTMUL) { const u32x2 f = *(const u32x2*)op; v0 *= bf_lo(f.x); v1 *= bf_hi(f.x); v2 *= bf_lo(f.y); v3 *= bf_hi(f.y); }
            u32x2 w; w.x = pkbf(v0, v1); w.y = pkbf(v2, v3); *(u32x2*)op = w; }
}

template <bool OUTMUL> __device__ __forceinline__ void memattn_phase(Frame& F) {
    bf16* QM = (bf16*)(F.ws + WS_QM); const bf16* KM = (const bf16*)(F.ws + WS_KMEM); const bf16* VT = (const bf16*)(F.ws + WS_VMEMT); bf16* SGY = (bf16*)(F.ws + WS_SGY);
    for (int task = F.gw; task < 512 * 4; task += F.NGW) { const int hm = task & 3, rb = task >> 2, row0 = rb * 32;
        bf16* op = OUTMUL ? SGY + (size_t)row0 * GWID + BR + hm * 64 : QM + (size_t)row0 * QMW + hm * 64;
        attn256_task<0, OUTMUL>(QM + (size_t)row0 * QMW + hm * 64, QMW, KM + hm * 64, 256, 0, VT + (size_t)(hm * 64) * 256, 256, op, OUTMUL ? GWID : QMW, nullptr, 0, 0.f, 0.f, F.lane); }
}
__device__ __forceinline__ void swa_phase(Frame& F, const int* pos, const float* sinks) {
    const bf16* RQ = (const bf16*)(F.ws + WS_RQ); const bf16* KS = (const bf16*)(F.ws + WS_KS); const bf16* VTS = (const bf16*)(F.ws + WS_VTS); bf16* SGY = (bf16*)(F.ws + WS_SGY);
    for (int task = F.gw; task < 512 * 32; task += F.NGW) {
        const int qh = task & 31, rb = task >> 5, row0 = rb * 32, blk = rb >> 2, kvh = qh >> 3;
        const float slope = __builtin_amdgcn_exp2f(-8.0f * (float)(qh + 1) / 32.0f);
        attn256_task<1, true>(RQ + (size_t)row0 * BR + qh * 64, BR, KS + kvh * 64, 256, (blk - 1) * 128, VTS + (size_t)(kvh * 64) * M, M, SGY + (size_t)row0 * GWID + qh * 64, GWID,
                              pos, row0, slope * LOG2E, sinks[qh] * LOG2E, F.lane);
    }
}

constexpr int DA_KP = 272, DA_KB = 16384, DA_VB = 16384, DA_BUF = DA_KB + DA_VB + 256, DA_QOFF = 2 * DA_BUF;
__device__ __forceinline__ void diffattn_phase(Frame& F, const Args& a) {
    bf16* RQ = (bf16*)(F.ws + WS_RQ); const bf16* RK = (const bf16*)(F.ws + WS_RK); const bf16* RVT = (const bf16*)(F.ws + WS_RV);
    const int* pos = (const int*)a.in[2]; const float* subln = (const float*)a.in[19];
    const int tid = F.tid, lane = F.lane, w = F.wave, r32 = lane & 31, hi = lane >> 5;
    float lam;
    { const float p1 = ((const float*)a.in[15])[lane] * ((const float*)a.in[16])[lane], p2 = ((const float*)a.in[17])[lane] * ((const float*)a.in[18])[lane];
      lam = expf(wave_sum(p1)) - expf(wave_sum(p2)) + LAM_INIT; }
    volatile LAS unsigned* MW = (volatile LAS unsigned*)(F.lds + MISC_OFF);
    unsigned* qctr = (unsigned*)(F.ws + WS_BAR) + 8192;
    const int* PM = (const int*)(F.ws + WS_MISC + 1024); const float* KN2f = (const float*)(F.ws + WS_MISC);
    for (;;) {
        if (tid == 0) { MW[16] = atomicAdd(qctr, 1u); MW[20] = 0u; }
        __syncthreads();
        const int L = (int)MW[16]; if (L >= 1024) break;
        const int qb = 63 - (L >> 4), h = 15 - (L & 15);
        const float sl2 = __builtin_amdgcn_exp2f(-8.0f * (float)(h + 1) / 16.0f) * LOG2E;
        const int q0 = qb * 256 + w * 32;
        LAS unsigned char* Ql = F.lds + DA_QOFF + w * (32 * DA_KP);
#pragma unroll
        for (int ii = 0; ii < 8; ++ii) { const int id = lane + 64 * ii, qr_ = id >> 4, qc_ = id & 15;
            *(LAS v4u*)(Ql + qr_ * DA_KP + qc_ * 16) = *(const v4u*)(RQ + (size_t)(q0 + qr_) * BR + h * 128 + qc_ * 8); }
        const LAS unsigned char* Qrd = Ql + r32 * DA_KP + hi * 16;
        const float kq = sl2 * (float)pos[q0 + r32];
        float qk[2];
#pragma unroll
        for (int c = 0; c < 2; ++c) { float sq_ = 0.f;
#pragma unroll
            for (int d0 = 0; d0 < 4; ++d0) { const v4u qv_ = *(const LAS v4u*)(Qrd + (c * 64 + d0 * 16) * 2);
                sq_ += (bf_lo(qv_.x) * bf_lo(qv_.x) + bf_hi(qv_.x) * bf_hi(qv_.x)) + (bf_lo(qv_.y) * bf_lo(qv_.y) + bf_hi(qv_.y) * bf_hi(qv_.y))
                     + (bf_lo(qv_.z) * bf_lo(qv_.z) + bf_hi(qv_.z) * bf_hi(qv_.z)) + (bf_lo(qv_.w) * bf_lo(qv_.w) + bf_hi(qv_.w) * bf_hi(qv_.w)); }
            sq_ += __shfl_xor(sq_, 32);
            qk[c] = sqrtf(sq_ * (KN2f[(h * 2 + c) * 2] + KN2f[(h * 2 + c) * 2 + 1])) * 1.02f + 0.01f; }
        float mrun[2] = {0.f, 0.f}, lrun[2] = {0.f, 0.f};
        f32x16 o[2][4];
#pragma unroll
        for (int c = 0; c < 2; ++c)
#pragma unroll
            for (int eb = 0; eb < 4; ++eb) o[c][eb] = (f32x16){};
        const int T_hi = 4 * qb + 3, t_mine = 4 * qb + (w >> 1);
        unsigned ksrc[2], vsrc[2];
#pragma unroll
        for (int p = 0; p < 2; ++p) { const int I = 2 * w + p; const int kr_ = 4 * I + (lane >> 4), kc_ = (lane & 15) ^ (kr_ & 15);
            ksrc[p] = (unsigned)(kr_ * BR + h * 128 + kc_ * 8);
            const int ve_ = 8 * I + (lane >> 3), vc_ = (lane & 7) ^ ((ve_ >> 1) & 7);
            vsrc[p] = (unsigned)((h * 128 + ve_) * M + vc_ * 8); }
#define DA_ISSUE(t, b) do { LAS unsigned char* B_ = F.lds + (b) * DA_BUF; \
        __builtin_amdgcn_global_load_lds((const unsigned*)(RK + (size_t)(ksrc[0] + (unsigned)(t) * 64u * BR)), (LAS unsigned*)(B_ + (2 * w) * 1024), 16, 0, 0); \
        __builtin_amdgcn_global_load_lds((const unsigned*)(RK + (size_t)(ksrc[1] + (unsigned)(t) * 64u * BR)), (LAS unsigned*)(B_ + (2 * w + 1) * 1024), 16, 0, 0); \
        __builtin_amdgcn_global_load_lds((const unsigned*)(RVT + (size_t)(vsrc[0] + (unsigned)(t) * 64u)), (LAS unsigned*)(B_ + DA_KB + (2 * w) * 1024), 16, 0, 0); \
        __builtin_amdgcn_global_load_lds((const unsigned*)(RVT + (size_t)(vsrc[1] + (unsigned)(t) * 64u)), (LAS unsigned*)(B_ + DA_KB + (2 * w + 1) * 1024), 16, 0, 0); \
        if (tid < 64) *(LAS float*)(B_ + DA_KB + DA_VB + tid * 4) = sl2 * (float)pos[(t) * 64 + tid]; } while (0)
        DA_ISSUE(T_hi, 0); asm volatile("s_waitcnt vmcnt(0) lgkmcnt(0)" ::: "memory"); __syncthreads();
        int b = 0, slot = 0; bool wdone = false;
        const int ksw = (r32 & 15), vsw = (r32 >> 1) & 7;
        for (int t = T_hi; ; --t, b ^= 1) {
            if (tid == 0) MW[20 + (slot == 2 ? 0 : slot + 1)] = 0u;
            if (t > 0) DA_ISSUE(t - 1, b ^ 1);
            if (t <= t_mine && !wdone) {
                const LAS unsigned char* Kl = F.lds + b * DA_BUF; const LAS unsigned char* Vl = Kl + DA_KB; const LAS float* kbf = (const LAS float*)(Kl + DA_KB + DA_VB);
                const bool need_mask = (t * 64 + 63 > q0);
#pragma unroll
                for (int c = 0; c < 2; ++c) {
#pragma unroll
                  for (int kvb = 0; kvb < 2; ++kvb) {
                    if (t * 64 + 32 * kvb > q0 + 31) continue;
                    const bool fst = (t == t_mine) && (kvb == 0);
                    f32x16 s0; const float cm = -kq - mrun[c];
#pragma unroll
                    for (int g = 0; g < 4; ++g) { const f32x4 k0 = *(const LAS f32x4*)(kbf + 32 * kvb + 8 * g + 4 * hi);
#pragma unroll
                        for (int j = 0; j < 4; ++j) { float v_ = k0[j] + cm; if (need_mask && k0[j] > kq) v_ = NEGBIG; s0[4 * g + j] = v_; } }
                    __builtin_amdgcn_sched_barrier(0);
#pragma unroll
                    for (int d0 = 0; d0 < 4; ++d0) { const int ch = ((8 * c + 2 * d0 + hi) ^ ksw) * 16;
                        const bf16x8 ka = *(const LAS bf16x8*)(Kl + (32 * kvb + r32) * 256 + ch);
                        const bf16x8 qv = *(const LAS bf16x8*)(Qrd + (c * 64 + d0 * 16) * 2);
                        s0 = __builtin_amdgcn_mfma_f32_32x32x16_bf16(ka, qv, s0, 0, 0, 0); }
                    __builtin_amdgcn_sched_barrier(0);
                    float mx = s0[0];
#pragma unroll
                    for (int r = 1; r < 16; ++r) mx = fmaxf(mx, s0[r]);
                    mx = fmaxf(mx, __shfl_xor(mx, 32));
                    if (fst || __any(mx > 8.0f)) {
                        const float dl = fst ? mx : fmaxf(mx, 0.f); mrun[c] += dl; const float al = __builtin_amdgcn_exp2f(-dl); lrun[c] *= al;
#pragma unroll
                        for (int r = 0; r < 16; ++r) s0[r] -= dl;
#pragma unroll
                        for (int eb = 0; eb < 4; ++eb) o[c][eb] *= al;
                    }
                    float ls = 0.f;
#pragma unroll
                    for (int r = 0; r < 16; ++r) { s0[r] = __builtin_amdgcn_exp2f(s0[r]); ls += s0[r]; }
                    lrun[c] += ls;
                    __builtin_amdgcn_sched_barrier(0);
#pragma unroll
                    for (int sh = 0; sh < 2; ++sh) { const int ks = 2 * kvb + sh;
                        v4u pw; pw.x = pkbf(s0[8 * sh + 0], s0[8 * sh + 1]); pw.y = pkbf(s0[8 * sh + 2], s0[8 * sh + 3]); pw.z = pkbf(s0[8 * sh + 4], s0[8 * sh + 5]); pw.w = pkbf(s0[8 * sh + 6], s0[8 * sh + 7]);
                        const bf16x8 pb = __builtin_bit_cast(bf16x8, pw); const int vch = ((2 * ks + hi) ^ vsw) * 16;
#pragma unroll
                        for (int eb = 0; eb < 4; ++eb) { const bf16x8 av = *(const LAS bf16x8*)(Vl + (32 * eb + r32) * 128 + vch);
                            o[c][eb] = __builtin_amdgcn_mfma_f32_32x32x16_bf16(av, pb, o[c][eb], 0, 0, 0); }
                        __builtin_amdgcn_sched_barrier(0);
                    }
                  }
                }
            }
            if (t > 0 && t <= t_mine && !wdone) {
                const float bnd = fmaxf(qk[0] - mrun[0], qk[1] - mrun[1]) - kq + sl2 * (float)PM[t - 1];
                if (!__any(bnd > -140.0f)) wdone = true;
            }
            if (t > 0 && !wdone && lane == 0) MW[20 + slot] = 1u;
            asm volatile("s_waitcnt vmcnt(0) lgkmcnt(0)" ::: "memory"); __syncthreads();
            if (t == 0 || MW[20 + slot] == 0u) break;
            slot = (slot == 2) ? 0 : slot + 1;
        }
#undef DA_ISSUE
        const float l0 = lrun[0] + __shfl_xor(lrun[0], 32), l1 = lrun[1] + __shfl_xor(lrun[1], 32);
        const float i0 = 1.0f / l0, i1 = lam / l1; float sq = 0.f;
#pragma unroll
        for (int eb = 0; eb < 4; ++eb)
#pragma unroll
            for (int r = 0; r < 16; ++r) { const float v2 = o[0][eb][r] * i0 - o[1][eb][r] * i1; o[0][eb][r] = v2; sq += v2 * v2; }
        sq += __shfl_xor(sq, 32);
        const float rn = (1.0f / sqrtf(sq * (1.0f / 128.0f) + EPS)) * (1.0f - LAM_INIT);
#pragma unroll
        for (int eb = 0; eb < 4; ++eb)
#pragma unroll
            for (int g = 0; g < 4; ++g) { const int e = 32 * eb + 8 * g + 4 * hi; const f32x4 sg = *(const f32x4*)(subln + e);
                u32x2 wv; wv.x = pkbf(o[0][eb][4 * g] * rn * sg[0], o[0][eb][4 * g + 1] * rn * sg[1]); wv.y = pkbf(o[0][eb][4 * g + 2] * rn * sg[2], o[0][eb][4 * g + 3] * rn * sg[3]);
                *(u32x2*)(RQ + (size_t)(q0 + r32) * BR + h * 128 + e) = wv; }
    }
}

struct Sched2 { pg8::StaticOrder so; int one, mine;
    __device__ __forceinline__ bool next(int i, pg8::Unit& u) const { if (one) { if (i > 0 || !mine) return false; u.pm = 0; u.pn = 0; return true; } return so.next(i, u); }
    __device__ __forceinline__ void a_ready(const pg8::Unit&) const {}
    __device__ __forceinline__ void done(const pg8::Unit&) const {} };

__global__ void __launch_bounds__(NWAVES * 64, 2) mega_fwd(Args args) {
    extern __shared__ __attribute__((aligned(16))) unsigned char lds_raw[];
    Frame F; F.lds = (LAS unsigned char*)lds_raw; F.tid = threadIdx.x; F.lane = F.tid & 63; F.wave = __builtin_amdgcn_readfirstlane(F.tid >> 6);
    F.G = gridDim.x; F.bx = blockIdx.x; F.gw = F.bx * NWAVES + F.wave; F.NGW = F.G * NWAVES; F.ws = args.ws;
    volatile LAS unsigned* MISC = (volatile LAS unsigned*)(F.lds + MISC_OFF);
    if (F.tid < 32) ((LAS unsigned*)(F.lds + MISC_OFF))[F.tid] = 0u;
    __syncthreads();
    const bool single = (args.ph_hi - args.ph_lo) > 1;
    XcdBarrier bar; bar.bar = (unsigned*)(F.ws + WS_BAR); bar.x = 0; bar.st = nullptr;
    if (single) bar = xcd_barrier_post((unsigned*)(F.ws + WS_BAR), MISC + 8);
    const float* rstd = (const float*)(F.ws + WS_RSTD); float* ss = (float*)(F.ws + WS_QM);
    const bf16* XB = (const bf16*)(F.ws + WS_XB); const bf16* WIN = (const bf16*)(F.ws + WS_WIN); const bf16* WOUT = (const bf16*)(F.ws + WS_WOUT); const bf16* WMEM = (const bf16*)(F.ws + WS_WMEM);
    const bf16* MEMN = (const bf16*)(F.ws + WS_MEMN);
    int ph = 0;
    for (int L = 0; L <= 4; ++L) {
        const int kind = (L == 3) ? 0 : L;
        const int nsub = (L == 4) ? 1 : (kind == 1) ? 5 : 4;
        for (int sub = 0; sub < nsub; ++sub, ++ph) {
            if (ph < args.ph_lo || ph >= args.ph_hi) continue;
            frame_refresh(F);
            int op = sub; if (kind != 1 && sub == 3) op = 4;
            if (op == 0) prep_phase(F, args, L);
            else if (op == 2) {
                if (kind == 0) { conv_phase(F, (const float*)args.in[(L == 0) ? 8 : 33]); memattn_phase<true>(F); }
                else if (kind == 1) { diffattn_phase(F, args); memattn_phase<false>(F); }
                else { swa_phase(F, (const int*)args.in[2], (const float*)args.in[26]); memattn_phase<true>(F); }
            } else {
                for (int j = 0; j < 4; ++j) {
                    Epi E{}; E.rstd = rstd; E.ws = F.ws; E.ss = ss; E.ldc = 256;
                    const bf16* A = XB; const bf16* Bt = WIN; int Mg = M, Ng = 0, Kg = D, one = 0, mine = 0; bool valid = true;
                    if (op == 1) {
                        const int nmain = (kind == 0) ? 1 : 2;
                        if (j == 0) { E.mode = (kind == 0) ? EM_CONV : (kind == 1) ? EM_DIFF1 : EM_SWA; Ng = (kind == 0) ? 8704 : (kind == 1) ? 4352 : 4864; }
                        else if (j < nmain) { E.mode = EM_VT; E.ldc = M; Bt = XB; Ng = M;
                            if (kind == 1) { A = WIN + (size_t)4352 * D; Mg = 2048; E.o0 = (bf16*)(F.ws + WS_RV); } else { A = WIN + (size_t)4864 * D; Mg = 256; E.o0 = (bf16*)(F.ws + WS_VTS); } }
                        else if (j == nmain) { E.mode = EM_PLAIN; A = MEMN; Bt = WMEM; Mg = 256; Ng = 256; one = 1; mine = (F.bx == F.G - 1); E.o0 = (bf16*)(F.ws + WS_KMEM); }
                        else if (j == nmain + 1) { E.mode = EM_VT; E.rstd = nullptr; A = WMEM + (size_t)256 * D; Bt = MEMN; Mg = 256; Ng = 256; one = 1; mine = (F.bx == F.G - 2); E.o0 = (bf16*)(F.ws + WS_VMEMT); }
                        else valid = false;
                    } else if (op == 3) { if (j == 0) { E.mode = EM_GATE; Bt = WIN + (size_t)6400 * D; Ng = GWID; } else valid = false; }
                    else { if (j == 0) { E.mode = EM_OUT; A = (const bf16*)(F.ws + WS_SGY); Bt = WOUT; Ng = D; Kg = GWID; } else valid = false; }
                    if (!valid) break;
                    pg8::Gemm g{A, Bt, Mg, Ng, Kg}; Sched2 S; S.so.init(Mg, Ng, F.G, F.bx); S.one = one; S.mine = mine;
                    pg8::gemm_phase<Epi, Sched2, true, true>(F.lds, g, S, E);
                }
            }
            if (single && ph + 1 < args.ph_hi) { if (ph == args.ph_lo) { __threadfence(); cg::this_grid().sync(); } else xcd_barrier(bar); }
        }
    }
}

constexpr int N_PHASES = 18;
#ifndef MK_PER_PHASE
#define MK_PER_PHASE 0
#endif
extern "C" void kernel_launch(void* const* d_in, const int* in_sizes, int n_in, void* d_out, int out_size, void* d_ws, size_t ws_size, hipStream_t stream) {
    static int ready = 0;
    if (!ready) {
        if (n_in != 35 || out_size != M * D || ws_size < WS_END) { fprintf(stderr, "kernel_launch: unexpected shapes (n_in %d out %d ws %zu)\n", n_in, out_size, ws_size); ready = -1; return; }
        if (hipFuncSetAttribute((const void*)mega_fwd, hipFuncAttributeMaxDynamicSharedMemorySize, LDS_BYTES) != hipSuccess) { fprintf(stderr, "hipFuncSetAttribute failed\n"); ready = -1; return; }
        ready = 1;
    }
    if (ready < 0) return;
    (void)hipMemsetAsync((char*)d_ws + WS_BAR, 0, 64 * KiB, stream);
    Args a{};
    for (int i = 0; i < 35; ++i) a.in[i] = d_in[i];
    a.out = (float*)d_out; a.ws = (unsigned char*)d_ws;
    const int grid = 256;
#if MK_PER_PHASE
    for (int p = 0; p < N_PHASES; ++p) { a.ph_lo = p; a.ph_hi = p + 1; hipLaunchKernelGGL(mega_fwd, dim3(grid), dim3(NWAVES * 64), LDS_BYTES, stream, a); }
#else
    a.ph_lo = 0; a.ph_hi = N_PHASES;
    void* kargs[] = {&a};
    hipError_t e = hipLaunchCooperativeKernel((const void*)mega_fwd, dim3(grid), dim3(NWAVES * 64), kargs, LDS_BYTES, stream);
    if (e != hipSuccess) fprintf(stderr, "cooperative launch failed: %s\n", hipGetErrorString(e));
#endif
}
```

```cpp
#include <hip/hip_runtime.h>
#include <hip/hip_cooperative_groups.h>
#include <cstdio>
#include <cstdint>
namespace cg = cooperative_groups;
namespace pg8 {
#define PG8_LAS __attribute__((address_space(3)))
typedef unsigned short bf16_t;
typedef short bf16x8 __attribute__((ext_vector_type(8)));
typedef float f32x4 __attribute__((ext_vector_type(4)));
typedef unsigned u32x4 __attribute__((ext_vector_type(4)));
constexpr int BM = 256, BK = 64, HALF = 128, HTB = HALF * BK * 2  , STAGE_BYTES = 8 * HTB, NXCD = 8, WGM = 8;

__host__ __device__ __forceinline__ int lds_byte(int r, int c) { const int st = (r >> 4) * 2 + (c >> 5), rr = r & 15, cc = c & 31, ob = rr * 64 + cc * 2; return st * 1024 + (ob ^ (((ob >> 9) & 1) << 5)); }
__host__ __device__ __forceinline__ void stage_rc(int b, int& R, int& C) { const int st = b / 1024, sb = b % 1024, swz = sb ^ (((sb >> 9) & 1) << 5); R = (st >> 1) * 16 + swz / 64; C = (st & 1) * 32 + (swz % 64) / 2; }
__host__ __device__ __forceinline__ int perm32(int rho) { const int n = rho >> 4, i = rho & 15; return 8 * (i >> 2) + 4 * n + (i & 3); }

struct Unit { int pm, pn; };
struct Gemm { const bf16_t* A; const bf16_t* Bt; int M, N, K; };

struct StaticOrder {
    int nM, nN, nwg, G, c;
    __host__ __device__ void init(int M, int N, int G_, int c_) { nM = M / BM; nN = N / BM; nwg = nM * nN; G = G_; c = c_; }
    __host__ __device__ bool next(int i, Unit& u) const {
        const long L = (long)i * G + c; if (L >= nwg) return false;
        int wgid = (int)L; { const int q = nwg / NXCD, r = nwg % NXCD, xcd = wgid % NXCD, off = wgid / NXCD; wgid = (xcd < r ? xcd * (q + 1) : r * (q + 1) + (xcd - r) * q) + off; }
        const int nig = WGM * nN, gid = wgid / nig, fm = gid * WGM, gsz = (nM - fm) < WGM ? (nM - fm) : WGM;
        u.pm = fm + ((wgid % nig) % gsz); u.pn = (wgid % nig) / gsz; return true;
    }
    __device__ __forceinline__ void a_ready(const Unit&) const {}
    __device__ __forceinline__ void done(const Unit&) const {}
};

__device__ __forceinline__ unsigned cvt_pk_bf16(float lo, float hi) { unsigned r; asm volatile("v_cvt_pk_bf16_f32 %0, %1, %2" : "=v"(r) : "v"(lo), "v"(hi)); return r; }
template <class Epi, class Sched, bool ALIGN_EPI = false, bool SP2 = false>
__device__ __forceinline__ void gemm_phase(PG8_LAS unsigned char* lds, const Gemm g, const Sched& S, const Epi& E) {
    int tid_ = threadIdx.x; asm volatile("" : "+v"(tid_)); const int tid = tid_, wid = __builtin_amdgcn_readfirstlane(tid >> 6), lane = tid & 63, wr = wid >> 2, wc = wid & 3, fr = lane & 15, fq = lane >> 4;
    const int K = g.K, nt = K / BK;
    unsigned voffA[2], voffB[2];
#pragma unroll
    for (int i = 0; i < 2; ++i) { int R, C; stage_rc(tid * 16 + i * 8192, R, C); const int Rb = Epi::PERM ? ((R & ~31) + perm32(R & 31)) : R;
        voffA[i] = (unsigned)(R * K + C) * 2u; voffB[i] = (unsigned)(Rb * K + C) * 2u; }
    const size_t kstep = (size_t)(BK * 2);
    const size_t hstep = (size_t)HALF * K * 2;
    const size_t tstep = 2 * hstep;
    const unsigned ldsw = (unsigned)wid * 1024u;
    const int aoff = lds_byte(wr * 64 + fr, fq * 8), boff = lds_byte(wc * 32 + fr, fq * 8);
#define PG8_SA(b, h) (((b) * 2 + (h)) * HTB)
#define PG8_SB(b, h) ((4 + (b) * 2 + (h)) * HTB)
#define PG8_STAGE(bufoff, gbase, voff) do { _Pragma("unroll") for (int _i = 0; _i < 2; ++_i) \
        __builtin_amdgcn_global_load_lds((const unsigned*)((const char*)(gbase) + (voff)[_i]), (PG8_LAS unsigned*)(lds + (bufoff) + ldsw + _i * 8192), 16, 0, 0); } while (0)
#define PG8_LDA(dst, b, h) do { _Pragma("unroll") for (int m = 0; m < 4; ++m) _Pragma("unroll") for (int k = 0; k < 2; ++k) dst[m][k] = *(const PG8_LAS bf16x8*)(lds + PG8_SA(b, h) + aoff + m * 2048 + k * 1024); } while (0)
#define PG8_LDB(dst, b, h) do { _Pragma("unroll") for (int n = 0; n < 2; ++n) _Pragma("unroll") for (int k = 0; k < 2; ++k) dst[n][k] = *(const PG8_LAS bf16x8*)(lds + PG8_SB(b, h) + boff + n * 2048 + k * 1024); } while (0)
#define PG8_MMA(ai, bj, At, Bt) do { __builtin_amdgcn_s_setprio(1); _Pragma("unroll") for (int m = 0; m < 4; ++m) _Pragma("unroll") for (int n = 0; n < 2; ++n) _Pragma("unroll") for (int k = 0; k < 2; ++k) \
        acc[ai][bj][m][n] = __builtin_amdgcn_mfma_f32_16x16x32_bf16(Bt[n][k], At[m][k], acc[ai][bj][m][n], 0, 0, 0); __builtin_amdgcn_s_setprio(0); } while (0)
#define PG8_WAIT_V(n) asm volatile("s_waitcnt vmcnt(" #n ")" ::: "memory")
#define PG8_WAIT_L(n) asm volatile("s_waitcnt lgkmcnt(" #n ")" ::: "memory")
#define PG8_BAR __builtin_amdgcn_s_barrier()
#define PG8_SCHED __builtin_amdgcn_sched_barrier(0)
    Unit cur, nxt; int ui = 0;
    if (!S.next(0, cur)) return;
    f32x4 acc[2][2][4][2];
#pragma unroll
    for (int a = 0; a < 2; ++a)
#pragma unroll
        for (int b = 0; b < 2; ++b)
#pragma unroll
            for (int m = 0; m < 4; ++m)
#pragma unroll
                for (int n = 0; n < 2; ++n) acc[a][b][m][n] = (f32x4){0.f, 0.f, 0.f, 0.f};
    bf16x8 At[4][2], B0[2][2], B1[2][2];
    const char* cA = (const char*)g.A + (size_t)cur.pm * tstep; const char* cB = (const char*)g.Bt + (size_t)cur.pn * tstep;
    S.a_ready(cur);
    if constexpr (SP2) {
        PG8_STAGE(PG8_SB(0, 0), cB, voffB); PG8_STAGE(PG8_SB(0, 1), cB + hstep, voffB); PG8_STAGE(PG8_SA(0, 0), cA, voffA); PG8_STAGE(PG8_SA(0, 1), cA + hstep, voffA);
        if (wr == 1) PG8_BAR;
        PG8_WAIT_V(2); PG8_BAR;
        PG8_STAGE(PG8_SB(1, 0), cB + kstep, voffB); PG8_STAGE(PG8_SA(1, 0), cA + kstep, voffA); PG8_STAGE(PG8_SB(1, 1), cB + hstep + kstep, voffB);
        PG8_WAIT_V(6); PG8_BAR;
    } else {
        PG8_STAGE(PG8_SB(0, 0), cB, voffB); PG8_STAGE(PG8_SA(0, 0), cA, voffA); PG8_STAGE(PG8_SB(0, 1), cB + hstep, voffB); PG8_STAGE(PG8_SA(0, 1), cA + hstep, voffA);
        if (wr == 1) PG8_BAR;
        PG8_WAIT_V(4); PG8_BAR;
        PG8_STAGE(PG8_SB(1, 0), cB + kstep, voffB); PG8_STAGE(PG8_SA(1, 0), cA + kstep, voffA); PG8_STAGE(PG8_SB(1, 1), cB + hstep + kstep, voffB);
        PG8_WAIT_V(6); PG8_BAR;
    }
    for (;;) {
        const bool has_next = S.next(ui + 1, nxt);
        const char* nA = has_next ? (const char*)g.A + (size_t)nxt.pm * tstep : cA; const char* nB = has_next ? (const char*)g.Bt + (size_t)nxt.pn * tstep : cB;
        for (int t = 0; t < nt; t += 2) {
            const bool last = (t == nt - 2);
            const char* a1 = cA + (size_t)(t + 1) * kstep;
            const char* a2 = last ? nA : cA + (size_t)(t + 2) * kstep; const char* b2 = last ? nB : cB + (size_t)(t + 2) * kstep;
            const char* a3 = a2 + kstep; const char* b3 = b2 + kstep;
            if (last && has_next) S.a_ready(nxt);
            if constexpr (SP2) {
            PG8_LDB(B0, 0, 0); PG8_LDB(B1, 0, 1); PG8_SCHED; PG8_LDA(At, 0, 0); PG8_STAGE(PG8_SA(1, 1), a1 + hstep, voffA);
            PG8_WAIT_V(8); PG8_WAIT_L(0); PG8_BAR; PG8_MMA(0, 0, At, B0); PG8_MMA(0, 1, At, B1); PG8_BAR; PG8_SCHED;
            PG8_LDA(At, 0, 1); PG8_STAGE(PG8_SB(0, 0), b2, voffB); PG8_STAGE(PG8_SB(0, 1), b2 + hstep, voffB); PG8_STAGE(PG8_SA(0, 0), a2, voffA);
            PG8_WAIT_V(8); PG8_WAIT_L(0); PG8_BAR; PG8_MMA(1, 0, At, B0); PG8_MMA(1, 1, At, B1); PG8_BAR; PG8_SCHED;
            PG8_LDB(B0, 1, 0); PG8_LDB(B1, 1, 1); PG8_SCHED; PG8_LDA(At, 1, 0); PG8_STAGE(PG8_SA(0, 1), a2 + hstep, voffA);
            PG8_WAIT_V(8); PG8_WAIT_L(0); PG8_BAR; PG8_MMA(0, 0, At, B0); PG8_MMA(0, 1, At, B1); PG8_BAR; PG8_SCHED;
            PG8_LDA(At, 1, 1); PG8_STAGE(PG8_SB(1, 0), b3, voffB); PG8_STAGE(PG8_SB(1, 1), b3 + hstep, voffB); PG8_STAGE(PG8_SA(1, 0), a3, voffA);
            PG8_WAIT_V(8); PG8_WAIT_L(0); PG8_BAR; PG8_MMA(1, 0, At, B0); PG8_MMA(1, 1, At, B1); PG8_BAR; PG8_SCHED;
            } else {
            PG8_LDB(B0, 0, 0); PG8_SCHED; PG8_LDA(At, 0, 0); PG8_STAGE(PG8_SA(1, 1), a1 + hstep, voffA);
            PG8_WAIT_L(8); PG8_BAR; PG8_WAIT_L(0); PG8_MMA(0, 0, At, B0); PG8_BAR; PG8_SCHED;
            PG8_LDB(B1, 0, 1); PG8_STAGE(PG8_SB(0, 0), b2, voffB);
            PG8_BAR; PG8_WAIT_L(0); PG8_MMA(0, 1, At, B1); PG8_BAR;
            PG8_LDA(At, 0, 1); PG8_STAGE(PG8_SA(0, 0), a2, voffA);
            PG8_BAR; PG8_WAIT_L(0); PG8_MMA(1, 0, At, B0); PG8_BAR; PG8_SCHED;
            PG8_STAGE(PG8_SB(0, 1), b2 + hstep, voffB);
            PG8_WAIT_V(6); PG8_BAR; PG8_MMA(1, 1, At, B1); PG8_BAR;
            PG8_LDB(B0, 1, 0); PG8_SCHED; PG8_LDA(At, 1, 0); PG8_STAGE(PG8_SA(0, 1), a2 + hstep, voffA);
            PG8_WAIT_L(8); PG8_BAR; PG8_WAIT_L(0); PG8_MMA(0, 0, At, B0); PG8_BAR; PG8_SCHED;
            PG8_LDB(B1, 1, 1); PG8_STAGE(PG8_SB(1, 0), b3, voffB);
            PG8_BAR; PG8_WAIT_L(0); PG8_MMA(0, 1, At, B1); PG8_BAR;
            PG8_LDA(At, 1, 1); PG8_STAGE(PG8_SA(1, 0), a3, voffA);
            PG8_BAR; PG8_WAIT_L(0); PG8_MMA(1, 0, At, B0); PG8_BAR; PG8_SCHED;
            PG8_STAGE(PG8_SB(1, 1), b3 + hstep, voffB);
            PG8_WAIT_V(6); PG8_BAR; PG8_MMA(1, 1, At, B1); PG8_BAR;
            }
        }
        if constexpr (ALIGN_EPI) { if (wr == 0) PG8_BAR; }
        if constexpr (!Epi::AFTER_DRAIN) { E(acc, cur, wr, wc, fr, fq); S.done(cur); }
        if (!has_next) break;
#pragma unroll
        for (int a = 0; a < 2; ++a)
#pragma unroll
            for (int b = 0; b < 2; ++b)
#pragma unroll
                for (int m = 0; m < 4; ++m)
#pragma unroll
                    for (int n = 0; n < 2; ++n) acc[a][b][m][n] = (f32x4){0.f, 0.f, 0.f, 0.f};
        cur = nxt; cA = nA; cB = nB; ++ui;
        if constexpr (ALIGN_EPI) { if (wr == 1) PG8_BAR; }
    }
    PG8_WAIT_V(0);
    if constexpr (!ALIGN_EPI) { if (wr == 0) PG8_BAR; }
    PG8_BAR;
    if constexpr (Epi::AFTER_DRAIN) { E.fused(acc, cur, wr, wc, fr, fq, lds, wid, lane); S.done(cur); }
#undef PG8_SA
#undef PG8_SB
#undef PG8_STAGE
#undef PG8_LDA
#undef PG8_LDB
#undef PG8_MMA
#undef PG8_WAIT_V
#undef PG8_WAIT_L
#undef PG8_BAR
#undef PG8_SCHED
}
}
#define GAS __attribute__((address_space(1)))
#define LAS __attribute__((address_space(3)))
typedef unsigned short bf16;
typedef unsigned v4u __attribute__((ext_vector_type(4)));
typedef float f32x4 __attribute__((ext_vector_type(4)));
typedef short bf16x8 __attribute__((ext_vector_type(8)));
typedef GAS unsigned gu32;
typedef GAS unsigned long long gu64;
#define RLX_AGENT __ATOMIC_RELAXED, __HIP_MEMORY_SCOPE_AGENT
#define LDS_WAIT() asm volatile("s_waitcnt lgkmcnt(0)" ::: "memory")
#define VM_WAIT() asm volatile("s_waitcnt vmcnt(0)" ::: "memory")
__device__ __forceinline__ unsigned long long rt() { return __builtin_amdgcn_s_memrealtime(); }
__device__ __forceinline__ unsigned f2bf(float f) { unsigned u = __builtin_bit_cast(unsigned, f); return (u + 0x7fffu + ((u >> 16) & 1u)) >> 16; }
__device__ __forceinline__ unsigned pk2(float lo, float hi) { return f2bf(lo) | (f2bf(hi) << 16); }

#define XB_TMO      128
#define XB_XCNT(j)  (256  + 64 * (j))
#define XB_XSUB(j)  (1280 + 64 * (j))
#define XB_XGEN(j)  (2304 + 64 * (j))
#define XB_TOP      3328
#define XB_TOPGEN   3392
#define XCD_BAR_WORDS 3456
#define XB_SPIN_CAP (1u << 18)

__device__ __forceinline__ unsigned xb_ld(unsigned* p)              { return __hip_atomic_load(p, __ATOMIC_RELAXED, __HIP_MEMORY_SCOPE_AGENT); }
__device__ __forceinline__ unsigned xb_add(unsigned* p, unsigned v) { return __hip_atomic_fetch_add(p, v, __ATOMIC_RELAXED, __HIP_MEMORY_SCOPE_AGENT); }
__device__ __forceinline__ unsigned xb_xcc_id() { return (unsigned)__builtin_amdgcn_s_getreg((3 << 11) | 20) & 0xFu; }
#define XB_SPIN(cond, bar) do { unsigned _sp = 0; while (cond) { __builtin_amdgcn_s_sleep(1); \
    if ((++_sp & 255u) == 0u) { if (xb_ld(&(bar)[XB_TMO])) break; if (_sp > XB_SPIN_CAP) { atomicAdd(&(bar)[XB_TMO], 1u); break; } } } } while (0)

struct XcdBarrier {
    unsigned* bar; unsigned x;
    volatile LAS unsigned* st;
};

__device__ __forceinline__ XcdBarrier xcd_barrier_post(unsigned* bar, volatile LAS unsigned* st) {
    XcdBarrier b; b.bar = bar; b.x = xb_xcc_id(); b.st = st;
    if (threadIdx.x == 0) (void)xb_add(&bar[XB_XCNT(b.x)], 1u);
    return b;
}
__device__ __forceinline__ void xcd_barrier_complete(unsigned* bar, unsigned x, unsigned& nloc, unsigned& nx) {
    const unsigned G = gridDim.x * gridDim.y * gridDim.z;
    unsigned sum, cnt, mine, sp = 0u;
    for (;;) {
        sum = 0u; cnt = 0u; mine = 0u;
#pragma unroll
        for (unsigned j = 0; j < 16; ++j) { const unsigned c = xb_ld(&bar[XB_XCNT(j)]); sum += c; cnt += (c > 0u) ? 1u : 0u; mine = (j == x) ? c : mine; }
        if (sum == G) break;
        __builtin_amdgcn_s_sleep(1);
        if ((++sp & 255u) == 0u) { if (xb_ld(&bar[XB_TMO])) break; if (sp > XB_SPIN_CAP) { atomicAdd(&bar[XB_TMO], 1u); break; } }
    }
    nloc = mine > 0u ? mine : 1u; nx = cnt > 0u ? cnt : 1u;
}

__device__ __forceinline__ void xcd_barrier(const XcdBarrier& b) {
    asm volatile("s_waitcnt vmcnt(0)" ::: "memory");
    __syncthreads();
    if (threadIdx.x == 0) {
        unsigned* bar = b.bar;
        __builtin_amdgcn_s_waitcnt(0);
        unsigned nloc = b.st[0], nx = b.st[1];
        if (nloc == 0u) { xcd_barrier_complete(bar, b.x, nloc, nx); b.st[0] = nloc; b.st[1] = nx; }
        const unsigned old = xb_add(&bar[XB_XSUB(b.x)], 1u);
        const unsigned gen = old / nloc;
        if (old + 1u == (gen + 1u) * nloc) {
            __builtin_amdgcn_fence(__ATOMIC_RELEASE, "agent");
            asm volatile("s_waitcnt vmcnt(0)" ::: "memory");
            const unsigned og = xb_add(&bar[XB_TOP], 1u);
            const unsigned tg = og / nx;
            if (og + 1u == (tg + 1u) * nx) xb_add(&bar[XB_TOPGEN], 1u);
            else XB_SPIN(xb_ld(&bar[XB_TOPGEN]) == tg, bar);
            __builtin_amdgcn_fence(__ATOMIC_ACQUIRE, "agent");
            xb_add(&bar[XB_XGEN(b.x)], 1u);
            asm volatile("s_waitcnt vmcnt(0)" ::: "memory");
        } else {
            XB_SPIN(xb_ld(&bar[XB_XGEN(b.x)]) == gen, bar);
            __builtin_amdgcn_fence(__ATOMIC_ACQUIRE, "agent");
            asm volatile("s_waitcnt vmcnt(0)" ::: "memory");
        }
    }
    __syncthreads();
}

constexpr int M = 16384, D = 1024, BR = 2048, GWID = 2304, QMW = 256;
constexpr float EPS = 1e-6f, LOG2E = 1.4426950408889634f, C2 = 0.125f * 1.4426950408889634f, NEGBIG = -1e30f;
constexpr float LAM_INIT = 0.35550907f;
typedef float f32x16 __attribute__((ext_vector_type(16)));
typedef unsigned u32x2 __attribute__((ext_vector_type(2)));
typedef int i32x4 __attribute__((ext_vector_type(4)));
typedef short s16x4 __attribute__((ext_vector_type(4)));

constexpr size_t MiB = 1u << 20, KiB = 1024;
constexpr size_t WS_BAR = 0;
constexpr size_t WS_RSTD = 64 * KiB, WS_SS = 128 * KiB, WS_KMEM = 192 * KiB, WS_VMEMT = 320 * KiB, WS_MEMN = 448 * KiB, WS_MISC = 960 * KiB;
constexpr size_t WS_WMEM = 1 * MiB, WS_WIN = 2 * MiB, WS_WOUT = 19 * MiB, WS_XB = 24 * MiB, WS_QM = 56 * MiB;
constexpr size_t WS_RQ = 64 * MiB, WS_RK = 128 * MiB, WS_RV = 192 * MiB, WS_END = 256 * MiB;
constexpr size_t WS_SGY = 128 * MiB;
constexpr size_t WS_KS = 200 * MiB, WS_VTS = 208 * MiB;
constexpr int LDS_BYTES = 147456, MISC_OFF = LDS_BYTES - 128;
constexpr int NWAVES = 8;

__device__ __forceinline__ float silu_f(float x) { return x * __builtin_amdgcn_rcpf(1.0f + __builtin_amdgcn_exp2f(-x * LOG2E)); }
__device__ __forceinline__ unsigned pkbf(float lo, float hi) { return pg8::cvt_pk_bf16(lo, hi); }
__device__ __forceinline__ float bf_lo(unsigned u) { return __uint_as_float(u << 16); }
__device__ __forceinline__ float bf_hi(unsigned u) { return __uint_as_float(u & 0xffff0000u); }

enum { EM_CONV = 0, EM_DIFF1, EM_VT, EM_GATE, EM_SWA, EM_PLAIN, EM_OUT };
struct Epi {
    static constexpr bool PERM = true, AFTER_DRAIN = false;
    int mode; int ldc; const float* rstd; unsigned char* ws; bf16* o0; float* ss;
    __device__ __forceinline__ void operator()(const pg8::f32x4 (&acc)[2][2][4][2], const pg8::Unit& u, int wr, int wc, int fr, int fq) const {
        using pg8::f32x4; typedef unsigned u32x4v __attribute__((ext_vector_type(4)));
        const int row0 = u.pm * 256 + wr * 64 + fr, tc8 = wc * 32 + fq * 8;
        bf16* RQ = (bf16*)(ws + WS_RQ); bf16* RK = (bf16*)(ws + WS_RK); bf16* QM = (bf16*)(ws + WS_QM); bf16* SGY = (bf16*)(ws + WS_SGY); bf16* KS = (bf16*)(ws + WS_KS);
#define ST8(ptr, a, b) do { u32x4v w_; w_.x = pkbf((a)[0], (a)[1]); w_.y = pkbf((a)[2], (a)[3]); w_.z = pkbf((b)[0], (b)[1]); w_.w = pkbf((b)[2], (b)[3]); *(u32x4v*)(ptr) = w_; } while (0)
        if (mode == EM_CONV) {
            if (u.pn < 32) {
                const int col = u.pn * 64 + wc * 16 + fq * 4;
#pragma unroll
                for (int ai = 0; ai < 2; ++ai)
#pragma unroll
                    for (int m = 0; m < 4; ++m) { const int row = row0 + ai * 128 + m * 16; const float rs = rstd[row];
                        const f32x4 bg = acc[ai][0][m][0] * rs, cgv = acc[ai][0][m][1] * rs, uu = acc[ai][1][m][0] * rs, gt = acc[ai][1][m][1] * rs;
                        const f32x4 z = cgv * uu; f32x4 b; b[0] = bg[0] * silu_f(gt[0]); b[1] = bg[1] * silu_f(gt[1]); b[2] = bg[2] * silu_f(gt[2]); b[3] = bg[3] * silu_f(gt[3]);
                        u32x2 zz; zz.x = pkbf(z[0], z[1]); zz.y = pkbf(z[2], z[3]); *(u32x2*)(RQ + (size_t)row * BR + col) = zz;
                        u32x2 bb; bb.x = pkbf(b[0], b[1]); bb.y = pkbf(b[2], b[3]); *(u32x2*)(SGY + (size_t)row * GWID + col) = bb; }
            } else {
                const int col = (u.pn - 32) * 128 + tc8;
#pragma unroll
                for (int ai = 0; ai < 2; ++ai)
#pragma unroll
                    for (int m = 0; m < 4; ++m) { const int row = row0 + ai * 128 + m * 16; const float rs = rstd[row]; const float rq = rs * C2;
                        const f32x4 q0 = acc[ai][0][m][0] * rq, q1 = acc[ai][0][m][1] * rq; ST8(QM + (size_t)row * QMW + col, q0, q1);
                        f32x4 g0 = acc[ai][1][m][0] * rs, g1 = acc[ai][1][m][1] * rs;
#pragma unroll
                        for (int j = 0; j < 4; ++j) { g0[j] = silu_f(g0[j]); g1[j] = silu_f(g1[j]); }
                        ST8(SGY + (size_t)row * GWID + BR + col, g0, g1); }
            }
        } else if (mode == EM_DIFF1 || mode == EM_SWA) {
            bf16* dst; int pitch; float sc = 1.f; int act = 0; const int pn = u.pn;
            if (pn < 8) { dst = RQ + pn * 256; pitch = BR; sc = C2; }
            else if (mode == EM_DIFF1) { if (pn < 16) { dst = RK + (pn - 8) * 256; pitch = BR; } else { dst = QM; pitch = QMW; sc = C2; } }
            else { if (pn == 8) { dst = KS; pitch = 256; } else if (pn == 9) { dst = QM; pitch = QMW; sc = C2; } else { dst = SGY + (pn - 10) * 256; pitch = GWID; act = 1; } }
#pragma unroll
            for (int ai = 0; ai < 2; ++ai)
#pragma unroll
                for (int m = 0; m < 4; ++m) { const int row = row0 + ai * 128 + m * 16; const float rs = rstd[row] * sc;
#pragma unroll
                    for (int bj = 0; bj < 2; ++bj) { f32x4 v0 = acc[ai][bj][m][0] * rs, v1 = acc[ai][bj][m][1] * rs;
                        if (act) {
#pragma unroll
                            for (int j = 0; j < 4; ++j) { v0[j] = silu_f(v0[j]); v1[j] = silu_f(v1[j]); } }
                        ST8(dst + (size_t)row * pitch + bj * 128 + tc8, v0, v1); } }
            if (mode == EM_DIFF1 && pn >= 8 && pn < 16) {
                unsigned* KN2 = (unsigned*)(ws + WS_MISC);
                asm volatile("" ::: "memory");
#pragma unroll
                for (int bj = 0; bj < 2; ++bj) { float q = 0.f;
#pragma unroll
                    for (int ai = 0; ai < 2; ++ai)
#pragma unroll
                        for (int m = 0; m < 4; ++m) { const float rs = rstd[row0 + ai * 128 + m * 16]; const f32x4 v0 = acc[ai][bj][m][0] * rs, v1 = acc[ai][bj][m][1] * rs;
                            q = fmaxf(q, (v0[0] * v0[0] + v0[1] * v0[1]) + (v0[2] * v0[2] + v0[3] * v0[3]) + (v1[0] * v1[0] + v1[1] * v1[1]) + (v1[2] * v1[2] + v1[3] * v1[3])); }
                    q += __shfl_xor(q, 16); q += __shfl_xor(q, 32);
                    q = fmaxf(q, __shfl_xor(q, 1)); q = fmaxf(q, __shfl_xor(q, 2)); q = fmaxf(q, __shfl_xor(q, 4)); q = fmaxf(q, __shfl_xor(q, 8));
                    if (fr == 0 && fq == 0) atomicMax(KN2 + ((pn - 8) * 4 + 2 * bj + (wc >> 1)) * 2 + (wc & 1), __float_as_uint(q)); }
            }
        } else if (mode == EM_VT) {
#pragma unroll
            for (int bj = 0; bj < 2; ++bj) { const int col = u.pn * 256 + bj * 128 + tc8; f32x4 r0 = {1.f, 1.f, 1.f, 1.f}, r1 = r0;
                if (rstd) { r0 = *(const f32x4*)(rstd + col); r1 = *(const f32x4*)(rstd + col + 4); }
                const int p0 = col - (fq & 1) * 8 + (fq & 1) * 4;
#pragma unroll
                for (int ai = 0; ai < 2; ++ai)
#pragma unroll
                    for (int m = 0; m < 4; ++m) { const int row = row0 + ai * 128 + m * 16; const f32x4 v0 = acc[ai][bj][m][0] * r0, v1 = acc[ai][bj][m][1] * r1;
                        u32x2 a_, b_; a_.x = pkbf(v0[0], v0[1]); a_.y = pkbf(v0[2], v0[3]); b_.x = pkbf(v1[0], v1[1]); b_.y = pkbf(v1[2], v1[3]);
                        *(u32x2*)(o0 + (size_t)row * ldc + p0) = a_; *(u32x2*)(o0 + (size_t)row * ldc + p0 + 8) = b_; } }
        } else if (mode == EM_GATE) {
            const int pn = u.pn; const bf16* src; int sp; if (pn < 8) { src = RQ + pn * 256; sp = BR; } else { src = QM; sp = QMW; }
            bf16* dst = SGY + pn * 256;
#pragma unroll
            for (int ai = 0; ai < 2; ++ai)
#pragma unroll
                for (int m = 0; m < 4; ++m) { const int row = row0 + ai * 128 + m * 16; const float rs = rstd[row];
#pragma unroll
                    for (int bj = 0; bj < 2; ++bj) { f32x4 v0 = acc[ai][bj][m][0] * rs, v1 = acc[ai][bj][m][1] * rs;
                        const u32x4v mx = *(const u32x4v*)(src + (size_t)row * sp + bj * 128 + tc8);
                        v0[0] = silu_f(v0[0]) * bf_lo(mx.x); v0[1] = silu_f(v0[1]) * bf_hi(mx.x); v0[2] = silu_f(v0[2]) * bf_lo(mx.y); v0[3] = silu_f(v0[3]) * bf_hi(mx.y);
                        v1[0] = silu_f(v1[0]) * bf_lo(mx.z); v1[1] = silu_f(v1[1]) * bf_hi(mx.z); v1[2] = silu_f(v1[2]) * bf_lo(mx.w); v1[3] = silu_f(v1[3]) * bf_hi(mx.w);
                        ST8(dst + (size_t)row * GWID + bj * 128 + tc8, v0, v1); } }
        } else if (mode == EM_PLAIN) {
#pragma unroll
            for (int ai = 0; ai < 2; ++ai)
#pragma unroll
                for (int m = 0; m < 4; ++m) { const int row = row0 + ai * 128 + m * 16;
#pragma unroll
                    for (int bj = 0; bj < 2; ++bj) ST8(o0 + (size_t)row * ldc + u.pn * 256 + bj * 128 + tc8, acc[ai][bj][m][0], acc[ai][bj][m][1]); }
        } else {
            float* YO = (float*)(ws + WS_RQ);
#pragma unroll
            for (int ai = 0; ai < 2; ++ai)
#pragma unroll
                for (int m = 0; m < 4; ++m) { const int row = row0 + ai * 128 + m * 16; float q = 0.f;
#pragma unroll
                    for (int bj = 0; bj < 2; ++bj) { const f32x4 v0 = acc[ai][bj][m][0], v1 = acc[ai][bj][m][1];
                        float* p = YO + (size_t)row * D + u.pn * 256 + bj * 128 + tc8; *(f32x4*)p = v0; *(f32x4*)(p + 4) = v1;
                        q += (v0[0] * v0[0] + v0[1] * v0[1]) + (v0[2] * v0[2] + v0[3] * v0[3]) + (v1[0] * v1[0] + v1[1] * v1[1]) + (v1[2] * v1[2] + v1[3] * v1[3]); }
                    q += __shfl_xor(q, 16); q += __shfl_xor(q, 32);
                    if (fq == 0) ss[(size_t)row * 16 + u.pn * 4 + wc] = q; }
        }
#undef ST8
    }
};
struct OneUnit { int has;
    __device__ __forceinline__ bool next(int i, pg8::Unit& u) const { if (i > 0 || !has) return false; u.pm = 0; u.pn = 0; return true; }
    __device__ __forceinline__ void a_ready(const pg8::Unit&) const {}
    __device__ __forceinline__ void done(const pg8::Unit&) const {} };

struct Args { const void* in[35]; float* out; unsigned char* ws; int ph_lo, ph_hi; };
struct Frame { LAS unsigned char* lds; int tid, lane, wave, G, bx, gw, NGW; unsigned char* ws; };
__device__ __forceinline__ void frame_refresh(Frame& F) { int t = threadIdx.x; asm volatile("" : "+v"(t)); F.tid = t; F.lane = t & 63; F.wave = __builtin_amdgcn_readfirstlane(t >> 6); F.gw = F.bx * NWAVES + F.wave; }

__device__ __forceinline__ float wave_sum(float v) {
#pragma unroll
    for (int o = 1; o < 64; o <<= 1) v += __shfl_xor(v, o);
    return v;
}
__device__ __forceinline__ int win_srccol(int kind, int n) {
    if (kind == 0) {
        const int pn = n >> 8, tc = n & 255;
        if (pn < 32) { const int bj = tc >> 7, wc = (tc >> 5) & 3, i = tc & 31, fq = i >> 3, nn = (i >> 2) & 1, j = i & 3, s = 2 * bj + nn;
            const int base = (s == 0) ? 0 : (s == 1) ? 2048 : (s == 2) ? 4096 : 6400; return base + pn * 64 + wc * 16 + fq * 4 + j; }
        const int t = pn - 32, bj = tc >> 7, c = tc & 127; return (bj == 0 ? 6144 : 6400 + 2048) + t * 128 + c;
    } else if (kind == 1) {
        if (n < 4096) return n; if (n < 4352) return 6144 + (n - 4096); if (n < 6400) return 4096 + (n - 4352); return n;
    } else {
        if (n < 2304) return n; if (n < 2560) return 2560 + (n - 2304); if (n < 4864) return 2816 + (n - 2560); return 2304 + (n - 4864);
    }
}
__device__ __forceinline__ void transpose_item(const float* W, int K, int Nsrc, const float* gain, int mapmode, bf16* WT, LAS float* scr, int item, int nblk, int lane) {
    const int kb = item / nblk, nb = item % nblk, k0 = 64 * kb, n0 = 32 * nb;
    const int nd = n0 + (lane & 31); const int sc = (mapmode < 0) ? nd : win_srccol(mapmode, nd);
#pragma unroll 8
    for (int i = 0; i < 32; ++i) { const int kk = 2 * i + (lane >> 5); float v = W[(size_t)(k0 + kk) * Nsrc + sc]; if (gain) v *= gain[k0 + kk]; scr[kk * 33 + (lane & 31)] = v; }
    LDS_WAIT(); asm volatile("" ::: "memory");
    const int c = lane & 7;
#pragma unroll
    for (int j = 0; j < 4; ++j) { const int n = (lane >> 3) + 8 * j; const LAS float* s = scr + (8 * c) * 33 + n;
        v4u o; o.x = pk2(s[0 * 33], s[1 * 33]); o.y = pk2(s[2 * 33], s[3 * 33]); o.z = pk2(s[4 * 33], s[5 * 33]); o.w = pk2(s[6 * 33], s[7 * 33]);
        *(GAS v4u*)(WT + (size_t)(n0 + n) * K + k0 + 8 * c) = o; }
    LDS_WAIT(); asm volatile("" ::: "memory");
}

__device__ __forceinline__ void prep_phase(Frame& F, const Args& a, int L) {
    float* rstd = (float*)(F.ws + WS_RSTD); float* ss = (float*)(F.ws + WS_QM); bf16* XB = (bf16*)(F.ws + WS_XB); const float* YO = (const float*)(F.ws + WS_RQ);
    const int base_prev = (L == 1) ? 3 : (L == 2) ? 10 : (L == 3) ? 21 : 28;
    const float* gpost = (L > 0) ? (const float*)a.in[base_prev + 1] : nullptr;
    const float* xin = (L <= 1) ? (const float*)a.in[0] : a.out;
    for (int m = F.gw; m < M; m += F.NGW) {
        const GAS f32x4* xr = (const GAS f32x4*)(xin + (size_t)m * D) + F.lane;
        f32x4 v[4];
#pragma unroll
        for (int j = 0; j < 4; ++j) v[j] = xr[64 * j];
        if (L > 0) {
            float ssum = 0.f; { const f32x4* sp = (const f32x4*)(ss + (size_t)m * 16); const f32x4 a0 = sp[0], a1 = sp[1], a2 = sp[2], a3 = sp[3];
                ssum = ((a0.x + a0.y) + (a0.z + a0.w)) + ((a1.x + a1.y) + (a1.z + a1.w)) + ((a2.x + a2.y) + (a2.z + a2.w)) + ((a3.x + a3.y) + (a3.z + a3.w)); }
            const float r = 1.0f / sqrtf(ssum * (1.0f / D) + EPS);
            const GAS f32x4* yr = (const GAS f32x4*)(YO + (size_t)m * D) + F.lane; const GAS f32x4* gp = (const GAS f32x4*)gpost + F.lane;
#pragma unroll
            for (int j = 0; j < 4; ++j) { const f32x4 y = yr[64 * j], g = gp[64 * j]; v[j] = v[j] + y * g * r; }
            GAS f32x4* xo = (GAS f32x4*)(a.out + (size_t)m * D) + F.lane;
#pragma unroll
            for (int j = 0; j < 4; ++j) xo[64 * j] = v[j];
        }
        if (L < 4) {
            float s2 = 0.f;
#pragma unroll
            for (int j = 0; j < 4; ++j) s2 += (v[j].x * v[j].x + v[j].y * v[j].y) + (v[j].z * v[j].z + v[j].w * v[j].w);
            s2 = wave_sum(s2);
            GAS unsigned long long* o8 = (GAS unsigned long long*)(XB + (size_t)m * D) + F.lane;
#pragma unroll
            for (int j = 0; j < 4; ++j) o8[64 * j] = (unsigned long long)pk2(v[j].x, v[j].y) | ((unsigned long long)pk2(v[j].z, v[j].w) << 32);
            if (F.lane == 0) rstd[m] = 1.0f / sqrtf(s2 * (1.0f / D) + EPS);
        }
    }
    if (L >= 4) return;
    if (L == 1 && F.bx == 0) {
        unsigned* KN2 = (unsigned*)(F.ws + WS_MISC); int* PM = (int*)(F.ws + WS_MISC + 1024); const int* pos = (const int*)a.in[2];
        if (F.tid < 64) KN2[F.tid] = 0u;
        LAS int* bm = (LAS int*)(F.lds + 8 * 16384);
        if (F.tid < 256) { int mxp = pos[F.tid * 64]; for (int j = 1; j < 64; ++j) mxp = max(mxp, pos[F.tid * 64 + j]); bm[F.tid] = mxp; }
        __syncthreads();
        if (F.tid < 256) { int mxp = bm[0]; for (int j = 1; j <= F.tid; ++j) mxp = max(mxp, bm[j]); PM[F.tid] = mxp; }
        __syncthreads();
    }
    const int base = (L == 0) ? 3 : (L == 1) ? 10 : (L == 2) ? 21 : 28; const int kind = (L == 3) ? 0 : L;
    const float* gpre = (const float*)a.in[base]; const float* gmem = (const float*)a.in[base + 2];
    const float* w_in = (const float*)a.in[base + 3]; const float* w_mem = (const float*)a.in[base + 4];
    const float* w_out = (const float*)a.in[(L == 0) ? 9 : (L == 1) ? 20 : (L == 2) ? 27 : 34];
    const int NIN = (kind == 2) ? 5120 : 8704;
    bf16* MEMN = (bf16*)(F.ws + WS_MEMN);
    for (int m = F.gw; m < 256; m += F.NGW) {
        const GAS f32x4* xr = (const GAS f32x4*)((const float*)a.in[1] + (size_t)m * D) + F.lane; const GAS f32x4* gp = (const GAS f32x4*)gmem + F.lane;
        f32x4 v[4]; float s2 = 0.f;
#pragma unroll
        for (int j = 0; j < 4; ++j) { v[j] = xr[64 * j]; s2 += (v[j].x * v[j].x + v[j].y * v[j].y) + (v[j].z * v[j].z + v[j].w * v[j].w); }
        const float r = 1.0f / sqrtf(wave_sum(s2) * (1.0f / D) + EPS);
        GAS unsigned long long* o8 = (GAS unsigned long long*)(MEMN + (size_t)m * D) + F.lane;
#pragma unroll
        for (int j = 0; j < 4; ++j) { const f32x4 g = gp[64 * j]; const f32x4 t = v[j] * g * r; o8[64 * j] = (unsigned long long)pk2(t.x, t.y) | ((unsigned long long)pk2(t.z, t.w) << 32); }
    }
    LAS float* scr = (LAS float*)(F.lds + F.wave * 16384);
    const int I_IN = (D / 64) * (NIN / 32), I_OUT = (GWID / 64) * (D / 32), I_MEM = (D / 64) * (512 / 32);
    for (int it = F.gw; it < I_IN + I_OUT + I_MEM; it += F.NGW) {
        int r = it;
        if (r < I_IN) { transpose_item(w_in, D, NIN, gpre, kind, (bf16*)(F.ws + WS_WIN), scr, r, NIN / 32, F.lane); continue; } r -= I_IN;
        if (r < I_OUT) { transpose_item(w_out, GWID, D, nullptr, -1, (bf16*)(F.ws + WS_WOUT), scr, r, D / 32, F.lane); continue; } r -= I_OUT;
        transpose_item(w_mem, D, 512, nullptr, -1, (bf16*)(F.ws + WS_WMEM), scr, r, 512 / 32, F.lane);
    }
}

__device__ __forceinline__ void conv_phase(Frame& F, const float* convw) {
    const bf16* Z = (const bf16*)(F.ws + WS_RQ); bf16* SGY = (bf16*)(F.ws + WS_SGY);
    const int nthreads = F.G * 512; const int gt = F.bx * 512 + F.tid;
    for (int task = gt; task < 256 * 512; task += nthreads) {
        const int cc = (task & 255) * 8, t0 = (task >> 8) * 32;
        float w0[8], w1[8], w2[8];
#pragma unroll
        for (int j = 0; j < 8; ++j) { w0[j] = convw[cc + j]; w1[j] = convw[BR + cc + j]; w2[j] = convw[2 * BR + cc + j]; }
        float za[8], zb[8];
        if (t0 >= 2) { const v4u a = *(const v4u*)(Z + (size_t)(t0 - 2) * BR + cc), b = *(const v4u*)(Z + (size_t)(t0 - 1) * BR + cc);
            za[0] = bf_lo(a.x); za[1] = bf_hi(a.x); za[2] = bf_lo(a.y); za[3] = bf_hi(a.y); za[4] = bf_lo(a.z); za[5] = bf_hi(a.z); za[6] = bf_lo(a.w); za[7] = bf_hi(a.w);
            zb[0] = bf_lo(b.x); zb[1] = bf_hi(b.x); zb[2] = bf_lo(b.y); zb[3] = bf_hi(b.y); zb[4] = bf_lo(b.z); zb[5] = bf_hi(b.z); zb[6] = bf_lo(b.w); zb[7] = bf_hi(b.w);
        } else {
#pragma unroll
            for (int j = 0; j < 8; ++j) { za[j] = 0.f; zb[j] = 0.f; } }
#pragma unroll 4
        for (int t = t0; t < t0 + 32; ++t) {
            const v4u c = *(const v4u*)(Z + (size_t)t * BR + cc); const v4u g = *(const v4u*)(SGY + (size_t)t * GWID + cc);
            float zc[8], gg[8];
            zc[0] = bf_lo(c.x); zc[1] = bf_hi(c.x); zc[2] = bf_lo(c.y); zc[3] = bf_hi(c.y); zc[4] = bf_lo(c.z); zc[5] = bf_hi(c.z); zc[6] = bf_lo(c.w); zc[7] = bf_hi(c.w);
            gg[0] = bf_lo(g.x); gg[1] = bf_hi(g.x); gg[2] = bf_lo(g.y); gg[3] = bf_hi(g.y); gg[4] = bf_lo(g.z); gg[5] = bf_hi(g.z); gg[6] = bf_lo(g.w); gg[7] = bf_hi(g.w);
            float o[8];
#pragma unroll
            for (int j = 0; j < 8; ++j) { o[j] = gg[j] * (w0[j] * za[j] + w1[j] * zb[j] + w2[j] * zc[j]); za[j] = zb[j]; zb[j] = zc[j]; }
            v4u w; w.x = pkbf(o[0], o[1]); w.y = pkbf(o[2], o[3]); w.z = pkbf(o[4], o[5]); w.w = pkbf(o[6], o[7]);
            *(v4u*)(SGY + (size_t)t * GWID + cc) = w;
        }
    }
}

template <int MODE, bool OUTMUL>
__device__ __forceinline__ void attn256_task(const bf16* Qp, int qpitch, const bf16* Kp, int kpitch, int krow0, const bf16* Vtp, int vpitch, bf16* Op, int opitch,
                                             const int* pos, int prow0, float sl2, float sink2, int lane) {
    const int r32 = lane & 31, hi = lane >> 5;
    bf16x8 qf[4];
#pragma unroll
    for (int d0 = 0; d0 < 4; ++d0) qf[d0] = *(const bf16x8*)(Qp + (size_t)r32 * qpitch + d0 * 16 + hi * 8);
    float mrun = (MODE == 1) ? sink2 : NEGBIG, den = 0.f; int pq = 0; if (MODE == 1) pq = pos[prow0 + r32];
    f32x16 o[2]; o[0] = (f32x16){}; o[1] = (f32x16){};
#pragma unroll
    for (int hb = 0; hb < 2; ++hb) {
        f32x16 s[4];
#pragma unroll
        for (int kq = 0; kq < 4; ++kq) { const int kb = 4 * hb + kq;
            int kr = krow0 + 32 * kb + r32; if (MODE == 1 && kr < 0) kr = 0;
            const bf16* kp = Kp + (size_t)kr * kpitch + hi * 8;
            f32x16 accv = {};
#pragma unroll
            for (int d0 = 0; d0 < 4; ++d0) { const bf16x8 kf = *(const bf16x8*)(kp + d0 * 16); accv = __builtin_amdgcn_mfma_f32_32x32x16_bf16(kf, qf[d0], accv, 0, 0, 0); }
            s[kq] = accv; __builtin_amdgcn_sched_barrier(0);
        }
        float mx = NEGBIG;
        if (MODE == 1) {
#pragma unroll
            for (int kq = 0; kq < 4; ++kq)
#pragma unroll
                for (int g = 0; g < 4; ++g) { const int sidx = 32 * (4 * hb + kq) + 8 * g + 4 * hi; int kr = krow0 + sidx; const bool kvalid = kr >= 0; if (kr < 0) kr = 0;
                    const i32x4 pk = *(const i32x4*)(pos + kr);
#pragma unroll
                    for (int j = 0; j < 4; ++j) { const int rel = pq - pk[j]; const bool ok = kvalid && rel >= 0 && rel < 128;
                        const float v = ok ? (s[kq][4 * g + j] - sl2 * (float)rel) : NEGBIG; s[kq][4 * g + j] = v; mx = fmaxf(mx, v); } }
        } else {
#pragma unroll
            for (int kq = 0; kq < 4; ++kq)
#pragma unroll
                for (int r = 0; r < 16; ++r) mx = fmaxf(mx, s[kq][r]);
        }
        mx = fmaxf(mx, __shfl_xor(mx, 32));
        const float mnew = fmaxf(mrun, mx), al = __builtin_amdgcn_exp2f(mrun - mnew); mrun = mnew; den *= al; o[0] *= al; o[1] *= al;
#pragma unroll
        for (int kq = 0; kq < 4; ++kq)
#pragma unroll
            for (int r = 0; r < 16; ++r) { const float p = __builtin_amdgcn_exp2f(s[kq][r] - mnew); s[kq][r] = p; den += p; }
        __builtin_amdgcn_sched_barrier(0);
#pragma unroll
        for (int kq = 0; kq < 4; ++kq)
#pragma unroll
            for (int sh = 0; sh < 2; ++sh) { const int kb = 4 * hb + kq;
                v4u pw; pw.x = pkbf(s[kq][8 * sh + 0], s[kq][8 * sh + 1]); pw.y = pkbf(s[kq][8 * sh + 2], s[kq][8 * sh + 3]); pw.z = pkbf(s[kq][8 * sh + 4], s[kq][8 * sh + 5]); pw.w = pkbf(s[kq][8 * sh + 6], s[kq][8 * sh + 7]);
                const bf16x8 pb = __builtin_bit_cast(bf16x8, pw);
                int vc = krow0 + 32 * kb + 16 * sh + 8 * hi; if (MODE == 1 && vc < 0) vc = 0;
#pragma unroll
                for (int eb = 0; eb < 2; ++eb) { const bf16x8 av = *(const bf16x8*)(Vtp + (size_t)(32 * eb + r32) * vpitch + vc);
                    o[eb] = __builtin_amdgcn_mfma_f32_32x32x16_bf16(av, pb, o[eb], 0, 0, 0); }
                __builtin_amdgcn_sched_barrier(0);
            }
    }
    den += __shfl_xor(den, 32);
    if (MODE == 1) den += __builtin_amdgcn_exp2f(sink2 - mrun);
    const float inv = 1.0f / den;
#pragma unroll
    for (int eb = 0; eb < 2; ++eb)
#pragma unroll
        for (int g = 0; g < 4; ++g) { bf16* op = Op + (size_t)r32 * opitch + 32 * eb + 8 * g + 4 * hi;
            float v0 = o[eb][4 * g] * inv, v1 = o[eb][4 * g + 1] * inv, v2 = o[eb][4 * g + 2] * inv, v3 = o[eb][4 * g + 3] * inv;
            if (OUTMUL) { const u32x2 f = *(const u32x2*)op; v0 *= bf_lo(f.x); v1 *= bf_hi(f.x); v2 *= bf_lo(f.y); v3 *= bf_hi(f.y); }
            u32x2 w; w.x = pkbf(v0, v1); w.y = pkbf(v2, v3); *(u32x2*)op = w; }
}

template <bool OUTMUL> __device__ __forceinline__ void memattn_phase(Frame& F) {
    bf16* QM = (bf16*)(F.ws + WS_QM); const bf16* KM = (const bf16*)(F.ws + WS_KMEM); const bf16* VT = (const bf16*)(F.ws + WS_VMEMT); bf16* SGY = (bf16*)(F.ws + WS_SGY);
    for (int task = F.gw; task < 512 * 4; task += F.NGW) { const int hm = task & 3, rb = task >> 2, row0 = rb * 32;
        bf16* op = OUTMUL ? SGY + (size_t)row0 * GWID + BR + hm * 64 : QM + (size_t)row0 * QMW + hm * 64;
        attn256_task<0, OUTMUL>(QM + (size_t)row0 * QMW + hm * 64, QMW, KM + hm * 64, 256, 0, VT + (size_t)(hm * 64) * 256, 256, op, OUTMUL ? GWID : QMW, nullptr, 0, 0.f, 0.f, F.lane); }
}
__device__ __forceinline__ void swa_phase(Frame& F, const int* pos, const float* sinks) {
    const bf16* RQ = (const bf16*)(F.ws + WS_RQ); const bf16* KS = (const bf16*)(F.ws + WS_KS); const bf16* VTS = (const bf16*)(F.ws + WS_VTS); bf16* SGY = (bf16*)(F.ws + WS_SGY);
    for (int task = F.gw; task < 512 * 32; task += F.NGW) {
        const int qh = task & 31, rb = task >> 5, row0 = rb * 32, blk = rb >> 2, kvh = qh >> 3;
        const float slope = __builtin_amdgcn_exp2f(-8.0f * (float)(qh + 1) / 32.0f);
        attn256_task<1, true>(RQ + (size_t)row0 * BR + qh * 64, BR, KS + kvh * 64, 256, (blk - 1) * 128, VTS + (size_t)(kvh * 64) * M, M, SGY + (size_t)row0 * GWID + qh * 64, GWID,
                              pos, row0, slope * LOG2E, sinks[qh] * LOG2E, F.lane);
    }
}

constexpr int DA_KB = 16384, DA_VB = 16384, DA_BUF = DA_KB + DA_VB + 256;
__device__ __forceinline__ void diffattn_phase(Frame& F, const Args& a) {
    bf16* RQ = (bf16*)(F.ws + WS_RQ); const bf16* RK = (const bf16*)(F.ws + WS_RK); const bf16* RVT = (const bf16*)(F.ws + WS_RV);
    const int* pos = (const int*)a.in[2]; const float* subln = (const float*)a.in[19];
    const int tid = F.tid, lane = F.lane, w = F.wave, r32 = lane & 31, hi = lane >> 5, rg = w & 3, c = w >> 2;
    float lam;
    { const float p1 = ((const float*)a.in[15])[lane] * ((const float*)a.in[16])[lane], p2 = ((const float*)a.in[17])[lane] * ((const float*)a.in[18])[lane];
      lam = expf(wave_sum(p1)) - expf(wave_sum(p2)) + LAM_INIT; }
    volatile LAS unsigned* MW = (volatile LAS unsigned*)(F.lds + MISC_OFF);
    unsigned* qctr = (unsigned*)(F.ws + WS_BAR) + 8192;
    const int* PM = (const int*)(F.ws + WS_MISC + 1024); const float* KN2f = (const float*)(F.ws + WS_MISC);
    for (;;) {
        if (tid == 0) { MW[16] = atomicAdd(qctr, 1u); MW[20] = 0u; }
        __syncthreads();
        const int L = (int)MW[16]; if (L >= 2048) break;
        const int qb = 127 - (L >> 4), h = 15 - (L & 15);
        const float sl2 = __builtin_amdgcn_exp2f(-8.0f * (float)(h + 1) / 16.0f) * LOG2E;
        const int q0 = qb * 128 + rg * 32;
        bf16x8 qf[4]; float sq_ = 0.f;
#pragma unroll
        for (int d0 = 0; d0 < 4; ++d0) { const v4u qv_ = *(const v4u*)(RQ + (size_t)(q0 + r32) * BR + h * 128 + c * 64 + d0 * 16 + hi * 8); qf[d0] = __builtin_bit_cast(bf16x8, qv_);
            sq_ += (bf_lo(qv_.x) * bf_lo(qv_.x) + bf_hi(qv_.x) * bf_hi(qv_.x)) + (bf_lo(qv_.y) * bf_lo(qv_.y) + bf_hi(qv_.y) * bf_hi(qv_.y))
                 + (bf_lo(qv_.z) * bf_lo(qv_.z) + bf_hi(qv_.z) * bf_hi(qv_.z)) + (bf_lo(qv_.w) * bf_lo(qv_.w) + bf_hi(qv_.w) * bf_hi(qv_.w)); }
        sq_ += __shfl_xor(sq_, 32);
        const float qk = sqrtf(sq_ * (KN2f[(h * 2 + c) * 2] + KN2f[(h * 2 + c) * 2 + 1])) * 1.02f + 0.01f;
        const float kq = sl2 * (float)pos[q0 + r32];
        float mrun = 0.f, lrun = 0.f;
        f32x16 o[4];
#pragma unroll
        for (int eb = 0; eb < 4; ++eb) o[eb] = (f32x16){};
        const int T_hi = 2 * qb + 1, t_mine = 2 * qb + (rg >> 1);
        unsigned ksrc[2], vsrc[2];
#pragma unroll
        for (int p = 0; p < 2; ++p) { const int I = 2 * w + p; const int kr_ = 4 * I + (lane >> 4), kc_ = (lane & 15) ^ (kr_ & 15);
            ksrc[p] = (unsigned)(kr_ * BR + h * 128 + kc_ * 8);
            const int ve_ = 8 * I + (lane >> 3), vc_ = (lane & 7) ^ ((ve_ >> 1) & 7);
            vsrc[p] = (unsigned)((h * 128 + ve_) * M + vc_ * 8); }
#define DA_ISSUE(t, b) do { LAS unsigned char* B_ = F.lds + (b) * DA_BUF; \
        __builtin_amdgcn_global_load_lds((const unsigned*)(RK + (size_t)(ksrc[0] + (unsigned)(t) * 64u * BR)), (LAS unsigned*)(B_ + (2 * w) * 1024), 16, 0, 0); \
        __builtin_amdgcn_global_load_lds((const unsigned*)(RK + (size_t)(ksrc[1] + (unsigned)(t) * 64u * BR)), (LAS unsigned*)(B_ + (2 * w + 1) * 1024), 16, 0, 0); \
        __builtin_amdgcn_global_load_lds((const unsigned*)(RVT + (size_t)(vsrc[0] + (unsigned)(t) * 64u)), (LAS unsigned*)(B_ + DA_KB + (2 * w) * 1024), 16, 0, 0); \
        __builtin_amdgcn_global_load_lds((const unsigned*)(RVT + (size_t)(vsrc[1] + (unsigned)(t) * 64u)), (LAS unsigned*)(B_ + DA_KB + (2 * w + 1) * 1024), 16, 0, 0); \
        if (tid < 64) *(LAS float*)(B_ + DA_KB + DA_VB + tid * 4) = sl2 * (float)pos[(t) * 64 + tid]; } while (0)
        DA_ISSUE(T_hi, 0); asm volatile("s_waitcnt vmcnt(0) lgkmcnt(0)" ::: "memory"); __syncthreads();
        int b = 0, slot = 0; bool wdone = false;
        const int ksw = (r32 & 15), vsw = (r32 >> 1) & 7;
        for (int t = T_hi; ; --t, b ^= 1) {
            if (tid == 0) MW[20 + (slot == 2 ? 0 : slot + 1)] = 0u;
            if (t > 0) DA_ISSUE(t - 1, b ^ 1);
            if (t <= t_mine && !wdone) {
                const LAS unsigned char* Kl = F.lds + b * DA_BUF; const LAS unsigned char* Vl = Kl + DA_KB; const LAS float* kbf = (const LAS float*)(Kl + DA_KB + DA_VB);
                const bool need_mask = (t * 64 + 63 > q0);
                f32x16 s0, s1; const float cm = -kq - mrun;
#pragma unroll
                for (int g = 0; g < 4; ++g) { const f32x4 k0 = *(const LAS f32x4*)(kbf + 8 * g + 4 * hi), k1 = *(const LAS f32x4*)(kbf + 32 + 8 * g + 4 * hi);
#pragma unroll
                    for (int j = 0; j < 4; ++j) { s0[4 * g + j] = k0[j] + cm; s1[4 * g + j] = k1[j] + cm; } }
#pragma unroll
                for (int d0 = 0; d0 < 4; ++d0) { const int ch = ((8 * c + 2 * d0 + hi) ^ ksw) * 16;
                    const bf16x8 ka = *(const LAS bf16x8*)(Kl + r32 * 256 + ch), kb2 = *(const LAS bf16x8*)(Kl + (32 + r32) * 256 + ch);
                    s0 = __builtin_amdgcn_mfma_f32_32x32x16_bf16(ka, qf[d0], s0, 0, 0, 0); s1 = __builtin_amdgcn_mfma_f32_32x32x16_bf16(kb2, qf[d0], s1, 0, 0, 0); }
                if (need_mask) {
#pragma unroll
                    for (int g = 0; g < 4; ++g) { const f32x4 k0 = *(const LAS f32x4*)(kbf + 8 * g + 4 * hi), k1 = *(const LAS f32x4*)(kbf + 32 + 8 * g + 4 * hi);
#pragma unroll
                        for (int j = 0; j < 4; ++j) { if (k0[j] > kq) s0[4 * g + j] = NEGBIG; if (k1[j] > kq) s1[4 * g + j] = NEGBIG; } } }
                float mx = fmaxf(s0[0], s1[0]);
#pragma unroll
                for (int r = 1; r < 16; ++r) mx = fmaxf(mx, fmaxf(s0[r], s1[r]));
                mx = fmaxf(mx, __shfl_xor(mx, 32));
                const bool fst = (t == t_mine);
                if (fst || __any(mx > 8.0f)) {
                    const float dl = fst ? mx : fmaxf(mx, 0.f); mrun += dl; const float al = __builtin_amdgcn_exp2f(-dl); lrun *= al;
#pragma unroll
                    for (int r = 0; r < 16; ++r) { s0[r] -= dl; s1[r] -= dl; }
#pragma unroll
                    for (int eb = 0; eb < 4; ++eb) o[eb] *= al;
                }
                float ls = 0.f;
#pragma unroll
                for (int r = 0; r < 16; ++r) { s0[r] = __builtin_amdgcn_exp2f(s0[r]); s1[r] = __builtin_amdgcn_exp2f(s1[r]); ls += s0[r] + s1[r]; }
                lrun += ls;
#pragma unroll
                for (int ks = 0; ks < 4; ++ks) {
                    const f32x16& sv = (ks < 2) ? s0 : s1; const int sh = ks & 1;
                    v4u pw; pw.x = pkbf(sv[8 * sh + 0], sv[8 * sh + 1]); pw.y = pkbf(sv[8 * sh + 2], sv[8 * sh + 3]); pw.z = pkbf(sv[8 * sh + 4], sv[8 * sh + 5]); pw.w = pkbf(sv[8 * sh + 6], sv[8 * sh + 7]);
                    const bf16x8 pb = __builtin_bit_cast(bf16x8, pw); const int vch = ((2 * ks + hi) ^ vsw) * 16;
#pragma unroll
                    for (int eb = 0; eb < 4; ++eb) { const bf16x8 av = *(const LAS bf16x8*)(Vl + (32 * eb + r32) * 128 + vch);
                        o[eb] = __builtin_amdgcn_mfma_f32_32x32x16_bf16(av, pb, o[eb], 0, 0, 0); }
                }
                if (t > 0) {
                    const float bnd = qk - mrun - kq + sl2 * (float)PM[t - 1];
                    if (!__any(bnd > -140.0f)) wdone = true;
                }
            }
            if (t > 0 && !wdone && lane == 0) MW[20 + slot] = 1u;
            asm volatile("s_waitcnt vmcnt(0) lgkmcnt(0)" ::: "memory"); __syncthreads();
            if (t == 0 || MW[20 + slot] == 0u) break;
            slot = (slot == 2) ? 0 : slot + 1;
        }
#undef DA_ISSUE
        const float ltot = lrun + __shfl_xor(lrun, 32);
        LAS float* X = (LAS float*)F.lds + rg * 4096 + lane;
        if (c == 1) { const float i1 = lam / ltot;
#pragma unroll
            for (int eb = 0; eb < 4; ++eb)
#pragma unroll
                for (int r = 0; r < 16; ++r) X[(eb * 16 + r) * 64] = o[eb][r] * i1; }
        asm volatile("s_waitcnt lgkmcnt(0)" ::: "memory"); __syncthreads();
        if (c == 0) { const float i0 = 1.0f / ltot; float sq = 0.f;
#pragma unroll
            for (int eb = 0; eb < 4; ++eb)
#pragma unroll
                for (int r = 0; r < 16; ++r) { const float v2 = o[eb][r] * i0 - X[(eb * 16 + r) * 64]; o[eb][r] = v2; sq += v2 * v2; }
            sq += __shfl_xor(sq, 32);
            const float rn = (1.0f / sqrtf(sq * (1.0f / 128.0f) + EPS)) * (1.0f - LAM_INIT);
#pragma unroll
            for (int eb = 0; eb < 4; ++eb)
#pragma unroll
                for (int g = 0; g < 4; ++g) { const int e = 32 * eb + 8 * g + 4 * hi; const f32x4 sg = *(const f32x4*)(subln + e);
                    u32x2 wv; wv.x = pkbf(o[eb][4 * g] * rn * sg[0], o[eb][4 * g + 1] * rn * sg[1]); wv.y = pkbf(o[eb][4 * g + 2] * rn * sg[2], o[eb][4 * g + 3] * rn * sg[3]);
                    *(u32x2*)(RQ + (size_t)(q0 + r32) * BR + h * 128 + e) = wv; }
        }
    }
}

struct Sched2 { pg8::StaticOrder so; int one, mine;
    __device__ __forceinline__ bool next(int i, pg8::Unit& u) const { if (one) { if (i > 0 || !mine) return false; u.pm = 0; u.pn = 0; return true; } return so.next(i, u); }
    __device__ __forceinline__ void a_ready(const pg8::Unit&) const {}
    __device__ __forceinline__ void done(const pg8::Unit&) const {} };

__global__ void __launch_bounds__(NWAVES * 64, 2) mega_fwd(Args args) {
    extern __shared__ __attribute__((aligned(16))) unsigned char lds_raw[];
    Frame F; F.lds = (LAS unsigned char*)lds_raw; F.tid = threadIdx.x; F.lane = F.tid & 63; F.wave = __builtin_amdgcn_readfirstlane(F.tid >> 6);
    F.G = gridDim.x; F.bx = blockIdx.x; F.gw = F.bx * NWAVES + F.wave; F.NGW = F.G * NWAVES; F.ws = args.ws;
    volatile LAS unsigned* MISC = (volatile LAS unsigned*)(F.lds + MISC_OFF);
    if (F.tid < 32) ((LAS unsigned*)(F.lds + MISC_OFF))[F.tid] = 0u;
    __syncthreads();
    const bool single = (args.ph_hi - args.ph_lo) > 1;
    XcdBarrier bar; bar.bar = (unsigned*)(F.ws + WS_BAR); bar.x = 0; bar.st = nullptr;
    if (single) bar = xcd_barrier_post((unsigned*)(F.ws + WS_BAR), MISC + 8);
    const float* rstd = (const float*)(F.ws + WS_RSTD); float* ss = (float*)(F.ws + WS_QM);
    const bf16* XB = (const bf16*)(F.ws + WS_XB); const bf16* WIN = (const bf16*)(F.ws + WS_WIN); const bf16* WOUT = (const bf16*)(F.ws + WS_WOUT); const bf16* WMEM = (const bf16*)(F.ws + WS_WMEM);
    const bf16* MEMN = (const bf16*)(F.ws + WS_MEMN);
    int ph = 0;
    for (int L = 0; L <= 4; ++L) {
        const int kind = (L == 3) ? 0 : L;
        const int nsub = (L == 4) ? 1 : (kind == 1) ? 5 : 4;
        for (int sub = 0; sub < nsub; ++sub, ++ph) {
            if (ph < args.ph_lo || ph >= args.ph_hi) continue;
            frame_refresh(F);
            int op = sub; if (kind != 1 && sub == 3) op = 4;
            if (op == 0) prep_phase(F, args, L);
            else if (op == 2) {
                if (kind == 0) { conv_phase(F, (const float*)args.in[(L == 0) ? 8 : 33]); memattn_phase<true>(F); }
                else if (kind == 1) { diffattn_phase(F, args); memattn_phase<false>(F); }
                else { swa_phase(F, (const int*)args.in[2], (const float*)args.in[26]); memattn_phase<true>(F); }
            } else {
                for (int j = 0; j < 4; ++j) {
                    Epi E{}; E.rstd = rstd; E.ws = F.ws; E.ss = ss; E.ldc = 256;
                    const bf16* A = XB; const bf16* Bt = WIN; int Mg = M, Ng = 0, Kg = D, one = 0, mine = 0; bool valid = true;
                    if (op == 1) {
                        const int nmain = (kind == 0) ? 1 : 2;
                        if (j == 0) { E.mode = (kind == 0) ? EM_CONV : (kind == 1) ? EM_DIFF1 : EM_SWA; Ng = (kind == 0) ? 8704 : (kind == 1) ? 4352 : 4864; }
                        else if (j < nmain) { E.mode = EM_VT; E.ldc = M; Bt = XB; Ng = M;
                            if (kind == 1) { A = WIN + (size_t)4352 * D; Mg = 2048; E.o0 = (bf16*)(F.ws + WS_RV); } else { A = WIN + (size_t)4864 * D; Mg = 256; E.o0 = (bf16*)(F.ws + WS_VTS); } }
                        else if (j == nmain) { E.mode = EM_PLAIN; A = MEMN; Bt = WMEM; Mg = 256; Ng = 256; one = 1; mine = (F.bx == F.G - 1); E.o0 = (bf16*)(F.ws + WS_KMEM); }
                        else if (j == nmain + 1) { E.mode = EM_VT; E.rstd = nullptr; A = WMEM + (size_t)256 * D; Bt = MEMN; Mg = 256; Ng = 256; one = 1; mine = (F.bx == F.G - 2); E.o0 = (bf16*)(F.ws + WS_VMEMT); }
                        else valid = false;
                    } else if (op == 3) { if (j == 0) { E.mode = EM_GATE; Bt = WIN + (size_t)6400 * D; Ng = GWID; } else valid = false; }
                    else { if (j == 0) { E.mode = EM_OUT; A = (const bf16*)(F.ws + WS_SGY); Bt = WOUT; Ng = D; Kg = GWID; } else valid = false; }
                    if (!valid) break;
                    pg8::Gemm g{A, Bt, Mg, Ng, Kg}; Sched2 S; S.so.init(Mg, Ng, F.G, F.bx); S.one = one; S.mine = mine;
                    pg8::gemm_phase<Epi, Sched2, true, true>(F.lds, g, S, E);
                }
            }
            if (single && ph + 1 < args.ph_hi) { if (ph == args.ph_lo) { __threadfence(); cg::this_grid().sync(); } else xcd_barrier(bar); }
        }
    }
}

constexpr int N_PHASES = 18;
#ifndef MK_PER_PHASE
#define MK_PER_PHASE 0
#endif
extern "C" void kernel_launch(void* const* d_in, const int* in_sizes, int n_in, void* d_out, int out_size, void* d_ws, size_t ws_size, hipStream_t stream) {
    static int ready = 0;
    if (!ready) {
        if (n_in != 35 || out_size != M * D || ws_size < WS_END) { fprintf(stderr, "kernel_launch: unexpected shapes (n_in %d out %d ws %zu)\n", n_in, out_size, ws_size); ready = -1; return; }
        if (hipFuncSetAttribute((const void*)mega_fwd, hipFuncAttributeMaxDynamicSharedMemorySize, LDS_BYTES) != hipSuccess) { fprintf(stderr, "hipFuncSetAttribute failed\n"); ready = -1; return; }
        ready = 1;
    }
    if (ready < 0) return;
    (void)hipMemsetAsync((char*)d_ws + WS_BAR, 0, 64 * KiB, stream);
    Args a{};
    for (int i = 0; i < 35; ++i) a.in[i] = d_in[i];
    a.out = (float*)d_out; a.ws = (unsigned char*)d_ws;
    const int grid = 256;
#if MK_PER_PHASE
    for (int p = 0; p < N_PHASES; ++p) { a.ph_lo = p; a.ph_hi = p + 1; hipLaunchKernelGGL(mega_fwd, dim3(grid), dim3(NWAVES * 64), LDS_BYTES, stream, a); }
#else
    a.ph_lo = 0; a.ph_hi = N_PHASES;
    void* kargs[] = {&a};
    hipError_t e = hipLaunchCooperativeKernel((const void*)mega_fwd, dim3(grid), dim3(NWAVES * 64), kargs, LDS_BYTES, stream);
    if (e != hipSuccess) fprintf(stderr, "cooperative launch failed: %s\n", hipGetErrorString(e));
#endif
}
```
